# Optimizing an MI355X kernel written in HIP

```python
import jax
import jax.numpy as jnp
from jax import lax
import numpy as np


D_MODEL = 1024
BATCH = 4
SEQ = 4096
DEPTH = 2

GRID_W = 64
CTX_LEN = 256
HEAD_DIM = 128
N_Q_HEADS = 8
N_KV_HEADS = 2
Q_PER_KV = N_Q_HEADS // N_KV_HEADS
ATTN_WIDTH = N_Q_HEADS * HEAD_DIM
KV_WIDTH = N_KV_HEADS * HEAD_DIM
WINDOW = 128
BLOCK = 128
BAND = BLOCK + 2 * WINDOW
N_FREQ = HEAD_DIM // 4
ROPE_BASE = 10000.0
D_RNN = D_MODEL
N_RNN_BLOCKS = 8
RNN_BLOCK_W = D_RNN // N_RNN_BLOCKS
CONV_W = 4
CONV_LEFT = 2
LRU_C = 8.0
N_BRANCH = 2
D_FF = ((8 * D_MODEL + 3 * 256 - 1) // (3 * 256)) * 256
IN_SIZES = (D_RNN, D_RNN, ATTN_WIDTH, KV_WIDTH, KV_WIDTH, N_BRANCH * D_MODEL)
IN_WIDTH = sum(IN_SIZES)
MOD_CHUNKS = 6
EPS = 1e-6
NEG_INF = -1e30

kernel_name = 'hybrid_rglru_swa_diffusion_block'


def _rms_norm(x, g):
    xf = x.astype(jnp.float32)
    y = xf * lax.rsqrt(jnp.mean(xf * xf, axis=-1, keepdims=True) + EPS)
    return y.astype(x.dtype) * g


def _split_in(p):
    offs = np.cumsum(IN_SIZES)[:-1].tolist()
    return jnp.split(p, offs, axis=-1)


def _rope_tables(seq_len):
    rows = seq_len // GRID_W
    row = jnp.repeat(jnp.arange(rows, dtype=jnp.int32), GRID_W)
    col = jnp.tile(jnp.arange(GRID_W, dtype=jnp.int32), rows)
    inv = ROPE_BASE ** (-jnp.arange(N_FREQ, dtype=jnp.float32) / N_FREQ)
    ang_r = row.astype(jnp.float32)[:, None] * inv[None, :]
    ang_c = col.astype(jnp.float32)[:, None] * inv[None, :]
    return (jnp.cos(ang_r), jnp.sin(ang_r), jnp.cos(ang_c), jnp.sin(ang_c))


def _rotate(x, cos, sin):
    x1, x2 = jnp.split(x, 2, axis=-1)
    cos = cos[None, :, None, :].astype(x.dtype)
    sin = sin[None, :, None, :].astype(x.dtype)
    return jnp.concatenate([x1 * cos - x2 * sin, x2 * cos + x1 * sin], axis=-1)


def _rope_2d(x, rope):
    cr, sr, cc, sc = rope
    xr, xc = jnp.split(x, 2, axis=-1)
    return jnp.concatenate([_rotate(xr, cr, sr), _rotate(xc, cc, sc)], axis=-1)


def _dwconv_centred(x, w, b):
    s = x.shape[1]
    xp = jnp.pad(x, ((0, 0), (CONV_LEFT, CONV_W - 1 - CONV_LEFT), (0, 0)))
    y = xp[:, 0:s] * w[0]
    for k in range(1, CONV_W):
        y = y + xp[:, k:k + s] * w[k]
    return y + b


def _block_diag(x, w, b):
    xb = x.reshape(x.shape[:-1] + (N_RNN_BLOCKS, RNN_BLOCK_W))
    y = jnp.einsum('bsni,nij->bsnj', xb, w)
    return y.reshape(x.shape) + b


def _lru_coeffs(x, wa, ba, wx, bx, lam):
    r = jax.nn.sigmoid(_block_diag(x, wa, ba)).astype(jnp.float32)
    i = jax.nn.sigmoid(_block_diag(x, wx, bx))
    log_a = LRU_C * r * jax.nn.log_sigmoid(lam.astype(jnp.float32))
    a = jnp.exp(log_a)
    b = jnp.sqrt(-jnp.expm1(2.0 * log_a)) * (i * x).astype(jnp.float32)
    return a, b


def _linear_scan(a, b, h0, reverse):
    def combine(l, r):
        return l[0] * r[0], r[0] * l[1] + r[1]
    a_cum, h = lax.associative_scan(combine, (a, b), axis=1, reverse=reverse)
    if h0 is None:
        return h
    return h + a_cum * h0[:, None, :]


def _rglru_branch(x_lat, x_ctx, conv_w, conv_b, wa, ba, wx, bx, lam, need_ctx):
    xl = _dwconv_centred(x_lat, conv_w, conv_b)
    xc = _dwconv_centred(x_ctx, conv_w, conv_b)
    ac_f, bc_f = _lru_coeffs(xc, wa[0], ba[0], wx[0], bx[0], lam[0])
    ac_b, bc_b = _lru_coeffs(xc, wa[1], ba[1], wx[1], bx[1], lam[1])
    hc_f = _linear_scan(ac_f, bc_f, None, False)
    hc_b = _linear_scan(ac_b, bc_b, None, True)
    al_f, bl_f = _lru_coeffs(xl, wa[0], ba[0], wx[0], bx[0], lam[0])
    al_b, bl_b = _lru_coeffs(xl, wa[1], ba[1], wx[1], bx[1], lam[1])
    hl = (_linear_scan(al_f, bl_f, hc_f[:, -1], False)
          + _linear_scan(al_b, bl_b, hc_b[:, 0], True))
    y_lat = hl.astype(x_lat.dtype)
    y_ctx = (hc_f + hc_b).astype(x_ctx.dtype) if need_ctx else None
    return y_lat, y_ctx


def _band(t, nb):
    n_side = WINDOW // BLOCK
    tp = jnp.pad(t, ((0, 0), (WINDOW, WINDOW), (0, 0), (0, 0)))
    tp = tp.reshape(t.shape[0], nb + 2 * n_side, BLOCK, t.shape[2], t.shape[3])
    return jnp.concatenate([tp[:, j:j + nb] for j in range(2 * n_side + 1)], axis=2)


def _latent_attention(q, k, v, kc, vc, sink):
    bsz, s = q.shape[0], q.shape[1]
    nb = s // BLOCK
    n_ctx = kc.shape[1]
    scale = HEAD_DIM ** -0.5
    qb = q.reshape(bsz, nb, BLOCK, N_KV_HEADS, Q_PER_KV, HEAD_DIM)
    kb = _band(k, nb)
    vb = _band(v, nb)
    s_band = jnp.einsum('bnqkgd,bnpkd->bnkgqp', qb, kb).astype(jnp.float32) * scale
    q_pos = jnp.arange(nb)[:, None] * BLOCK + jnp.arange(BLOCK)[None, :]
    k_pos = jnp.arange(nb)[:, None] * BLOCK - WINDOW + jnp.arange(BAND)[None, :]
    kp = k_pos[:, None, :]
    valid = (jnp.abs(kp - q_pos[:, :, None]) <= WINDOW) & (kp >= 0) & (kp < s)
    s_band = jnp.where(valid[None, :, None, None], s_band, NEG_INF)
    s_ctx = jnp.einsum('bnqkgd,bckd->bnkgqc', qb, kc).astype(jnp.float32) * scale
    s_sink = jnp.broadcast_to(
        sink.astype(jnp.float32).reshape(1, 1, N_KV_HEADS, Q_PER_KV, 1, 1),
        s_band.shape[:-1] + (1,))
    p = jax.nn.softmax(jnp.concatenate([s_band, s_ctx, s_sink], axis=-1), axis=-1)
    p_band = p[..., :BAND].astype(v.dtype)
    p_ctx = p[..., BAND:BAND + n_ctx].astype(v.dtype)
    o = (jnp.einsum('bnkgqp,bnpkd->bnqkgd', p_band, vb)
         + jnp.einsum('bnkgqc,bckd->bnqkgd', p_ctx, vc))
    return o.reshape(bsz, s, ATTN_WIDTH)


def _context_attention(qc, kc, vc, sink):
    bsz, n_ctx = qc.shape[0], qc.shape[1]
    scale = HEAD_DIM ** -0.5
    qg = qc.reshape(bsz, n_ctx, N_KV_HEADS, Q_PER_KV, HEAD_DIM)
    sc = jnp.einsum('bqkgd,bckd->bkgqc', qg, kc).astype(jnp.float32) * scale
    s_sink = jnp.broadcast_to(
        sink.astype(jnp.float32).reshape(1, N_KV_HEADS, Q_PER_KV, 1, 1),
        sc.shape[:-1] + (1,))
    p = jax.nn.softmax(jnp.concatenate([sc, s_sink], axis=-1), axis=-1)
    o = jnp.einsum('bkgqc,bckd->bqkgd', p[..., :n_ctx].astype(vc.dtype), vc)
    return o.reshape(bsz, n_ctx, ATTN_WIDTH)


def _merge(y_rnn, g_rnn, y_attn, gate_logits, w_o_rnn, w_o_attn, w_out):
    ya = (y_rnn * jax.nn.gelu(g_rnn)) @ w_o_rnn
    yb = y_attn @ w_o_attn
    ga, gb = jnp.split(jax.nn.sigmoid(gate_logits), N_BRANCH, axis=-1)
    return (ga * ya + gb * yb) @ w_out


def _mixer(h, hc, rope, w_in, conv_w, conv_b, wa, ba, wx, bx, lam, sink,
           w_o_rnn, w_o_attn, w_out, need_ctx):
    bsz, s = h.shape[0], h.shape[1]
    n_ctx = hc.shape[1]
    xr, gr, q, k, v, gl = _split_in(h @ w_in)
    xrc, grc, qc, kc, vc, glc = _split_in(hc @ w_in)
    y_rnn, y_rnn_c = _rglru_branch(xr, xrc, conv_w, conv_b, wa, ba, wx, bx, lam, need_ctx)
    q = _rope_2d(q.reshape(bsz, s, N_Q_HEADS, HEAD_DIM), rope)
    k = _rope_2d(k.reshape(bsz, s, N_KV_HEADS, HEAD_DIM), rope)
    v = v.reshape(bsz, s, N_KV_HEADS, HEAD_DIM)
    kc = kc.reshape(bsz, n_ctx, N_KV_HEADS, HEAD_DIM)
    vc = vc.reshape(bsz, n_ctx, N_KV_HEADS, HEAD_DIM)
    o = _latent_attention(q, k, v, kc, vc, sink)
    out = _merge(y_rnn, gr, o, gl, w_o_rnn, w_o_attn, w_out)
    out_c = None
    if need_ctx:
        oc = _context_attention(qc.reshape(bsz, n_ctx, N_Q_HEADS, HEAD_DIM), kc, vc, sink)
        out_c = _merge(y_rnn_c, grc, oc, glc, w_o_rnn, w_o_attn, w_out)
    return out, out_c


def _swiglu(h, w_ffn_in, w_ffn_out):
    gate, up = jnp.split(h @ w_ffn_in, 2, axis=-1)
    return (jax.nn.silu(gate) * up) @ w_ffn_out


def setup_inputs(seed: int = 0) -> dict:
    key = jax.random.key(seed)
    ks = jax.random.split(key, 24)
    f32 = jnp.float32

    def nrm(k, shape, scale):
        return jax.random.normal(k, shape, f32) * scale

    L = DEPTH
    a0 = jax.random.uniform(ks[15], (L, 2, D_RNN), f32, 0.9, 0.999)
    return {
        'x': nrm(ks[0], (BATCH, SEQ, D_MODEL), 1.0),
        'c': nrm(ks[1], (BATCH, D_MODEL), 1.0),
        'ctx': nrm(ks[2], (BATCH, CTX_LEN, D_MODEL), 1.0),
        'c_ctx': nrm(ks[3], (D_MODEL,), 1.0),
        'w_mod': nrm(ks[4], (L, D_MODEL, MOD_CHUNKS * D_MODEL), 0.5 * D_MODEL ** -0.5),
        'b_mod': nrm(ks[5], (L, MOD_CHUNKS * D_MODEL), 0.02),
        'g_mix_pre': 1.0 + nrm(ks[6], (L, D_MODEL), 0.02),
        'g_mix_post': 1.0 + nrm(ks[7], (L, D_MODEL), 0.02),
        'g_ffn_pre': 1.0 + nrm(ks[8], (L, D_MODEL), 0.02),
        'g_ffn_post': 1.0 + nrm(ks[9], (L, D_MODEL), 0.02),
        'w_in': nrm(ks[10], (L, D_MODEL, IN_WIDTH), D_MODEL ** -0.5),
        'conv_w': nrm(ks[11], (L, CONV_W, D_RNN), CONV_W ** -0.5),
        'conv_b': nrm(ks[12], (L, D_RNN), 0.02),
        'lru_wa': nrm(ks[13], (L, 2, N_RNN_BLOCKS, RNN_BLOCK_W, RNN_BLOCK_W), RNN_BLOCK_W ** -0.5),
        'lru_ba': nrm(ks[14], (L, 2, D_RNN), 0.02),
        'lru_wx': nrm(ks[16], (L, 2, N_RNN_BLOCKS, RNN_BLOCK_W, RNN_BLOCK_W), RNN_BLOCK_W ** -0.5),
        'lru_bx': nrm(ks[17], (L, 2, D_RNN), 0.02),
        'lru_lam': jnp.log(a0) - jnp.log1p(-a0),
        'attn_sink': nrm(ks[18], (L, N_Q_HEADS), 0.5),
        'w_o_rnn': nrm(ks[19], (L, D_RNN, D_MODEL), D_RNN ** -0.5),
        'w_o_attn': nrm(ks[20], (L, ATTN_WIDTH, D_MODEL), ATTN_WIDTH ** -0.5),
        'w_out': nrm(ks[21], (L, D_MODEL, D_MODEL), D_MODEL ** -0.5),
        'w_ffn_in': nrm(ks[22], (L, D_MODEL, 2 * D_FF), D_MODEL ** -0.5),
        'w_ffn_out': nrm(ks[23], (L, D_FF, D_MODEL), D_FF ** -0.5),
    }


def reference(x, c, ctx, c_ctx, w_mod, b_mod, g_mix_pre, g_mix_post, g_ffn_pre,
              g_ffn_post, w_in, conv_w, conv_b, lru_wa, lru_ba, lru_wx, lru_bx,
              lru_lam, attn_sink, w_o_rnn, w_o_attn, w_out, w_ffn_in, w_ffn_out):
    rope = _rope_tables(x.shape[1])
    for l in range(DEPTH):
        need_ctx = l < DEPTH - 1
        mod = jax.nn.silu(c) @ w_mod[l] + b_mod[l]
        sh1, sc1, ga1, sh2, sc2, ga2 = jnp.split(mod[:, None, :], MOD_CHUNKS, axis=-1)
        mod_c = jax.nn.silu(c_ctx) @ w_mod[l] + b_mod[l]
        sh1c, sc1c, ga1c, sh2c, sc2c, ga2c = jnp.split(mod_c, MOD_CHUNKS, axis=-1)

        h = _rms_norm(x, g_mix_pre[l]) * (1.0 + sc1) + sh1
        hc = _rms_norm(ctx, g_mix_pre[l]) * (1.0 + sc1c) + sh1c
        m, mc = _mixer(h, hc, rope, w_in[l], conv_w[l], conv_b[l], lru_wa[l], lru_ba[l],
                       lru_wx[l], lru_bx[l], lru_lam[l], attn_sink[l], w_o_rnn[l],
                       w_o_attn[l], w_out[l], need_ctx)
        x = x + ga1 * _rms_norm(m, g_mix_post[l])
        if need_ctx:
            ctx = ctx + ga1c * _rms_norm(mc, g_mix_post[l])

        h = _rms_norm(x, g_ffn_pre[l]) * (1.0 + sc2) + sh2
        x = x + ga2 * _rms_norm(_swiglu(h, w_ffn_in[l], w_ffn_out[l]), g_ffn_post[l])
        if need_ctx:
            hc = _rms_norm(ctx, g_ffn_pre[l]) * (1.0 + sc2c) + sh2c
            ctx = ctx + ga2c * _rms_norm(_swiglu(hc, w_ffn_in[l], w_ffn_out[l]), g_ffn_post[l])
    return x
```

```cpp
#include <hip/hip_runtime.h>
#include <hip/hip_cooperative_groups.h>
#include <cstdio>
#include <cstdint>
namespace cg = cooperative_groups;

#ifndef MK_PER_PHASE
#define MK_PER_PHASE 0
#endif

#define LAS __attribute__((address_space(3)))
typedef unsigned short bf16_t;
typedef short bf16x8 __attribute__((ext_vector_type(8)));
typedef short s16x4 __attribute__((ext_vector_type(4)));
typedef float f32x4 __attribute__((ext_vector_type(4)));
typedef float f32x2 __attribute__((ext_vector_type(2)));
typedef float f32x16 __attribute__((ext_vector_type(16)));
typedef unsigned u32x4 __attribute__((ext_vector_type(4)));
typedef unsigned u32x2 __attribute__((ext_vector_type(2)));

constexpr int DM = 1024, NB = 4, SEQ = 4096, CTX = 256;
constexpr int ML = NB * SEQ, MC = NB * CTX, MT = ML + MC;
constexpr int INW = 5632, DFF = 2816, NCH = 68;
constexpr float EPS = 1e-6f;
constexpr int NPHASE = 20;

constexpr size_t MB1 = (size_t)MT * 1024 * 2;
constexpr size_t OFF_W = 0;
constexpr size_t W_WIN = 0, W_WG = 11534336, W_WOR = W_WG + 1048576, W_WOA = W_WOR + 2097152, W_WOUT = W_WOA + 2097152;
constexpr size_t W_WFI = 0, W_WFO = 11534336;
constexpr size_t OFF_CTX = 18874368;
constexpr size_t OFF_MOD = OFF_CTX + 4194304;
constexpr size_t OFF_AGG = OFF_MOD + 245760;
constexpr size_t OFF_X = OFF_AGG + 4456448;
constexpr size_t OFF_GR = OFF_X + MB1;
constexpr size_t OFF_Q = OFF_GR + MB1;
constexpr size_t OFF_KV = OFF_Q + MB1;
constexpr size_t OFF_GL = OFF_KV + (size_t)MT * 512 * 2;
constexpr size_t OFF_Y = OFF_GL + (size_t)MT * 2048 * 2;
constexpr size_t OFF_CTL = OFF_Y + MB1, CTL_BYTES = 16384;
constexpr size_t OFF_TAB = OFF_CTL + CTL_BYTES, TAB_BYTES = 64 * 32 * 8;
constexpr size_t WS_END = OFF_TAB + TAB_BYTES;
constexpr size_t OFF_A2 = OFF_GR;
constexpr size_t OFF_F = OFF_CTL - (size_t)MT * 1024 * 4;
constexpr size_t OFF_MX = OFF_GL;
static_assert(OFF_A2 + (size_t)MT * DFF * 2 <= OFF_F, "A2/F overlap");
static_assert(WS_END <= 268435456, "workspace");

constexpr int LDS_BYTES = 163840;
constexpr int LDS_BARST = LDS_BYTES - 64;

__device__ __forceinline__ unsigned cvt_pk_bf16(float lo, float hi) { unsigned r; asm volatile("v_cvt_pk_bf16_f32 %0, %1, %2" : "=v"(r) : "v"(lo), "v"(hi)); return r; }
__device__ __forceinline__ float bf2f(unsigned short v) { return __uint_as_float(((unsigned)v) << 16); }
__device__ __forceinline__ float bflo(unsigned w) { return __uint_as_float(w << 16); }
__device__ __forceinline__ float bfhi(unsigned w) { return __uint_as_float(w & 0xffff0000u); }
__device__ __forceinline__ float sigmoidf_(float x) { return __builtin_amdgcn_rcpf(1.0f + __expf(-x)); }
__device__ __forceinline__ float siluf_(float x) { return x * __builtin_amdgcn_rcpf(1.0f + __expf(-x)); }
__device__ __forceinline__ float gelu_tanh(float x) { const float u = 0.7978845608028654f * (x + 0.044715f * x * x * x); const float t = 1.0f - 2.0f * __builtin_amdgcn_rcpf(1.0f + __expf(2.0f * u)); return 0.5f * x * (1.0f + t); }
__device__ __forceinline__ float wave_sum(float v, int lane) {
#pragma unroll
    for (int o = 1; o < 64; o <<= 1) v += __uint_as_float(__builtin_amdgcn_ds_bpermute((lane ^ o) << 2, __float_as_uint(v)));
    return v;
}

namespace pg8 {
constexpr int BM = 256, BK = 64, HALF = 128, HTB = HALF * BK * 2, STAGE_BYTES = 8 * HTB, NXCD = 8, WGM = 8;
__device__ __forceinline__ int lds_byte(int r, int c) { const int st = (r >> 4) * 2 + (c >> 5), rr = r & 15, cc = c & 31, ob = rr * 64 + cc * 2; return st * 1024 + (ob ^ (((ob >> 9) & 1) << 5)); }
__device__ __forceinline__ void stage_rc(int b, int& R, int& C) { const int st = b / 1024, sb = b % 1024, swz = sb ^ (((sb >> 9) & 1) << 5); R = (st >> 1) * 16 + swz / 64; C = (st & 1) * 32 + (swz % 64) / 2; }
__device__ __forceinline__ int perm32(int rho) { const int n = rho >> 4, i = rho & 15; return 8 * (i >> 2) + 4 * n + (i & 3); }

struct Unit { int pm, pn; const char* A; const char* B; int chain; int nt; int slab; };

struct TileMap {
    int nM, nN, nwg, G, c;
    __device__ void init(int M, int N, int G_, int c_) { nM = M / BM; nN = N / BM; nwg = nM * nN; G = G_; c = c_; }
    __device__ bool tile(int i, int& pm, int& pn) const {
        const long L = (long)i * G + c; if (L >= nwg) return false;
        int wgid = (int)L; { const int q = nwg / NXCD, r = nwg % NXCD, xcd = wgid % NXCD, off = wgid / NXCD; wgid = (xcd < r ? xcd * (q + 1) : r * (q + 1) + (xcd - r) * q) + off; }
        const int nig = WGM * nN, gid = wgid / nig, fm = gid * WGM, gsz = (nM - fm) < WGM ? (nM - fm) : WGM;
        pm = fm + ((wgid % nig) % gsz); pn = (wgid % nig) / gsz; return true;
    }
};
struct PlainOrder {
    TileMap tm; const char* A; const char* B; size_t tsA, tsB; int nt;
    __device__ bool next(int i, Unit& u) const { if (!tm.tile(i, u.pm, u.pn)) return false; u.A = A + (size_t)u.pm * tsA; u.B = B + (size_t)u.pn * tsB; u.chain = 0; u.nt = nt; u.slab = -1; return true; }
};
struct SplitOrder {
    TileMap tm; const char* A; const char* B; size_t tsA, tsB; int nt; int G, c; int nslice; int ka, kb;
    __device__ bool next(int i, Unit& u) const {
        const long L = (long)i * G + c;
        if (L < 256) { if (!tm.tile(i, u.pm, u.pn)) return false; u.A = A + (size_t)u.pm * tsA; u.B = B + (size_t)u.pn * tsB; u.chain = 0; u.nt = nt; u.slab = -1; return true; }
        const int j = (int)(L - 256); if (j >= nslice) return false;
        const int t = j >> 2, sl = j & 3; u.pm = 64 + (t >> 2); u.pn = t & 3; u.chain = 0; u.slab = sl;
        const int kk = sl < 2 ? ka * sl : 2 * ka + kb * (sl - 2); u.nt = sl < 2 ? ka : kb;
        u.A = A + (size_t)u.pm * tsA + (size_t)kk * 128; u.B = B + (size_t)u.pn * tsB + (size_t)kk * 128; return true;
    }
};
struct ChainOrder {
    TileMap tm; const char* A0; const char* B0; const char* A1; const char* B1; size_t tsA, tsB; int nt; int G, c, nslice;
    __device__ bool next(int i, Unit& u) const { const int part = i & 1; u.chain = part ? 0 : 1;
        if (nslice == 0) { if (!tm.tile(i >> 1, u.pm, u.pn)) return false; u.nt = nt; u.slab = -1;
            u.A = (part ? A1 : A0) + (size_t)u.pm * tsA; u.B = (part ? B1 : B0) + (size_t)u.pn * tsB; return true; }
        const long L = (long)(i >> 1) * G + c;
        if (L < 256) { if (!tm.tile(i >> 1, u.pm, u.pn)) return false; u.nt = nt; u.slab = -1;
            u.A = (part ? A1 : A0) + (size_t)u.pm * tsA; u.B = (part ? B1 : B0) + (size_t)u.pn * tsB; return true; }
        const int j = (int)(L - 256); if (j >= nslice) return false;
        const int t = j >> 2, sl = j & 3; u.pm = 64 + (t >> 2); u.pn = t & 3; u.slab = sl; u.nt = 4;
        u.A = (part ? A1 : A0) + (size_t)u.pm * tsA + (size_t)sl * 512; u.B = (part ? B1 : B0) + (size_t)u.pn * tsB + (size_t)sl * 512; return true; }
};

template <bool CHAIN, class Epi, class Sched>
__device__ __forceinline__ void gemm_phase(LAS unsigned char* lds, const int tid, const int K, const int lda, const int ldb, const Sched& S, const Epi& E) {
    const int wid = __builtin_amdgcn_readfirstlane(tid >> 6), lane = tid & 63, wr = wid >> 2, wc = wid & 3, fr = lane & 15, fq = lane >> 4;
    unsigned voffA[2], voffB[2];
#pragma unroll
    for (int i = 0; i < 2; ++i) { int R, C; stage_rc(tid * 16 + i * 8192, R, C); const int Rb = Epi::PERM ? ((R & ~31) + perm32(R & 31)) : R;
        voffA[i] = (unsigned)(R * lda + C) * 2u; voffB[i] = (unsigned)(Rb * ldb + C) * 2u; }
    const size_t kstep = (size_t)(BK * 2);
    const size_t hstepA = (size_t)HALF * lda * 2, hstepB = (size_t)HALF * ldb * 2;
    const unsigned ldsw = (unsigned)wid * 1024u;
    const int aoff = lds_byte(wr * 64 + fr, fq * 8), boff = lds_byte(wc * 32 + fr, fq * 8);
#define PG8_SA(b, h) (((b) * 2 + (h)) * HTB)
#define PG8_SB(b, h) ((4 + (b) * 2 + (h)) * HTB)
#define PG8_STAGE(bufoff, gbase, voff) do { _Pragma("unroll") for (int _i = 0; _i < 2; ++_i) \
        __builtin_amdgcn_global_load_lds((const unsigned*)((const char*)(gbase) + (voff)[_i]), (LAS unsigned*)(lds + (bufoff) + ldsw + _i * 8192), 16, 0, 0); } while (0)
#define PG8_LDA(dst, b, h) do { _Pragma("unroll") for (int m = 0; m < 4; ++m) _Pragma("unroll") for (int k = 0; k < 2; ++k) dst[m][k] = *(const LAS bf16x8*)(lds + PG8_SA(b, h) + aoff + m * 2048 + k * 1024); } while (0)
#define PG8_LDB(dst, b, h) do { _Pragma("unroll") for (int n = 0; n < 2; ++n) _Pragma("unroll") for (int k = 0; k < 2; ++k) dst[n][k] = *(const LAS bf16x8*)(lds + PG8_SB(b, h) + boff + n * 2048 + k * 1024); } while (0)
#define PG8_MMA(ai, bj, At, Bt) do { __builtin_amdgcn_s_setprio(1); _Pragma("unroll") for (int m = 0; m < 4; ++m) _Pragma("unroll") for (int n = 0; n < 2; ++n) _Pragma("unroll") for (int k = 0; k < 2; ++k) \
        acc[ai][bj][m][n] = __builtin_amdgcn_mfma_f32_16x16x32_bf16(Bt[n][k], At[m][k], acc[ai][bj][m][n], 0, 0, 0); __builtin_amdgcn_s_setprio(0); } while (0)
#define PG8_WAIT_V(n) asm volatile("s_waitcnt vmcnt(" #n ")" ::: "memory")
#define PG8_WAIT_L(n) asm volatile("s_waitcnt lgkmcnt(" #n ")" ::: "memory")
#define PG8_BAR __builtin_amdgcn_s_barrier()
#define PG8_SCHED __builtin_amdgcn_sched_barrier(0)
#define PG8_KLOOP(cA_, cB_, nA_, nB_, nt_) do { const int nt__ = (nt_); \
        for (int t = 0; t < nt__; t += 2) { \
            const bool last = (t == nt__ - 2); \
            const char* a1 = (cA_) + (size_t)(t + 1) * kstep; \
            const char* a2 = last ? (nA_) : (cA_) + (size_t)(t + 2) * kstep; const char* b2 = last ? (nB_) : (cB_) + (size_t)(t + 2) * kstep; \
            const char* a3 = a2 + kstep; const char* b3 = b2 + kstep; \
            PG8_LDB(B0, 0, 0); PG8_LDB(B1, 0, 1); PG8_SCHED; PG8_LDA(At, 0, 0); PG8_STAGE(PG8_SA(1, 1), a1 + hstepA, voffA); \
            PG8_WAIT_V(8); PG8_WAIT_L(0); PG8_BAR; PG8_MMA(0, 0, At, B0); PG8_MMA(0, 1, At, B1); PG8_BAR; PG8_SCHED; \
            PG8_LDA(At, 0, 1); PG8_STAGE(PG8_SB(0, 0), b2, voffB); PG8_STAGE(PG8_SB(0, 1), b2 + hstepB, voffB); PG8_STAGE(PG8_SA(0, 0), a2, voffA); \
            PG8_WAIT_V(8); PG8_WAIT_L(0); PG8_BAR; PG8_MMA(1, 0, At, B0); PG8_MMA(1, 1, At, B1); PG8_BAR; PG8_SCHED; \
            PG8_LDB(B0, 1, 0); PG8_LDB(B1, 1, 1); PG8_SCHED; PG8_LDA(At, 1, 0); PG8_STAGE(PG8_SA(0, 1), a2 + hstepA, voffA); \
            PG8_WAIT_V(8); PG8_WAIT_L(0); PG8_BAR; PG8_MMA(0, 0, At, B0); PG8_MMA(0, 1, At, B1); PG8_BAR; PG8_SCHED; \
            PG8_LDA(At, 1, 1); PG8_STAGE(PG8_SB(1, 0), b3, voffB); PG8_STAGE(PG8_SB(1, 1), b3 + hstepB, voffB); PG8_STAGE(PG8_SA(1, 0), a3, voffA); \
            PG8_WAIT_V(8); PG8_WAIT_L(0); PG8_BAR; PG8_MMA(1, 0, At, B0); PG8_MMA(1, 1, At, B1); PG8_BAR; PG8_SCHED; \
        } } while (0)
#define PG8_EPI_IDS int l2_ = lane; asm volatile("" : "+v"(l2_)); const int fr2 = l2_ & 15, fq2 = l2_ >> 4
    Unit cur, nxt; int ui = 0;
    if (!S.next(0, cur)) return;
    f32x4 acc[2][2][4][2];
#pragma unroll
    for (int a = 0; a < 2; ++a)
#pragma unroll
        for (int b = 0; b < 2; ++b)
#pragma unroll
            for (int m = 0; m < 4; ++m)
#pragma unroll
                for (int n = 0; n < 2; ++n) acc[a][b][m][n] = (f32x4){0.f, 0.f, 0.f, 0.f};
    bf16x8 At[4][2], B0[2][2], B1[2][2];
    {
        const char* cA = cur.A; const char* cB = cur.B;
        PG8_STAGE(PG8_SB(0, 0), cB, voffB); PG8_STAGE(PG8_SB(0, 1), cB + hstepB, voffB); PG8_STAGE(PG8_SA(0, 0), cA, voffA); PG8_STAGE(PG8_SA(0, 1), cA + hstepA, voffA);
        if (wr == 1) PG8_BAR;
        PG8_WAIT_V(2); PG8_BAR;
        PG8_STAGE(PG8_SB(1, 0), cB + kstep, voffB); PG8_STAGE(PG8_SA(1, 0), cA + kstep, voffA); PG8_STAGE(PG8_SB(1, 1), cB + hstepB + kstep, voffB);
        PG8_WAIT_V(6); PG8_BAR;
    }
    for (;;) {
        bool has_next;
        if constexpr (CHAIN) {
            Unit c2; (void)S.next(ui + 1, c2);
            PG8_KLOOP(cur.A, cur.B, c2.A, c2.B, cur.nt);
            if (wr == 0) PG8_BAR;
            { PG8_EPI_IDS; E.mid(acc, cur, wr, wc, fr2, fq2); }
            if (wr == 1) PG8_BAR;
            ++ui;
            has_next = S.next(ui + 1, nxt);
            const char* nA = has_next ? nxt.A : c2.A; const char* nB = has_next ? nxt.B : c2.B;
            PG8_KLOOP(c2.A, c2.B, nA, nB, c2.nt);
            if (wr == 0) PG8_BAR;
            { PG8_EPI_IDS; E(acc, c2, wr, wc, fr2, fq2); }
        } else {
            has_next = S.next(ui + 1, nxt);
            const char* nA = has_next ? nxt.A : cur.A; const char* nB = has_next ? nxt.B : cur.B;
            PG8_KLOOP(cur.A, cur.B, nA, nB, cur.nt);
            if (wr == 0) PG8_BAR;
            { PG8_EPI_IDS; E(acc, cur, wr, wc, fr2, fq2); }
        }
        if (!has_next) break;
#pragma unroll
        for (int a = 0; a < 2; ++a)
#pragma unroll
            for (int b = 0; b < 2; ++b)
#pragma unroll
                for (int m = 0; m < 4; ++m)
#pragma unroll
                    for (int n = 0; n < 2; ++n) acc[a][b][m][n] = (f32x4){0.f, 0.f, 0.f, 0.f};
        cur = nxt; ++ui;
        if (wr == 1) PG8_BAR;
    }
    PG8_WAIT_V(0);
    PG8_BAR;
#undef PG8_SA
#undef PG8_SB
#undef PG8_STAGE
#undef PG8_LDA
#undef PG8_LDB
#undef PG8_MMA
#undef PG8_WAIT_V
#undef PG8_WAIT_L
#undef PG8_BAR
#undef PG8_SCHED
#undef PG8_KLOOP
#undef PG8_EPI_IDS
}

struct EpiInProj {
    static constexpr bool PERM = true;
    bf16_t *XR, *GR, *Q, *KV, *GL; const float* TAB;
    __device__ __forceinline__ void mid(f32x4 (&acc)[2][2][4][2], const Unit& u, int wr, int wc, int fr, int fq) const {}
    template <int LDC> __device__ __forceinline__ void store(const f32x4 (&acc)[2][2][4][2], bf16_t* base, int row0) const {
        bf16_t* rp = base + (size_t)row0 * LDC;
#pragma unroll
        for (int ai = 0; ai < 2; ++ai)
#pragma unroll
            for (int m = 0; m < 4; ++m) { bf16_t* rowp = rp + (size_t)(ai * HALF + m * 16) * LDC;
#pragma unroll
                for (int bj = 0; bj < 2; ++bj) { const f32x4 v0 = acc[ai][bj][m][0], v1 = acc[ai][bj][m][1];
                    u32x4 w; w.x = cvt_pk_bf16(v0[0], v0[1]); w.y = cvt_pk_bf16(v0[2], v0[3]); w.z = cvt_pk_bf16(v1[0], v1[1]); w.w = cvt_pk_bf16(v1[2], v1[3]);
                    *(u32x4*)(rowp + bj * HALF) = w; } }
    }
    template <int LDC> __device__ __forceinline__ void store_rope(const f32x4 (&acc)[2][2][4][2], bf16_t* base, int row0, int wc, int fq) const {
        bf16_t* rp = base + (size_t)row0 * LDC; const int axis = wc >> 1, f0 = 16 * (wc & 1) + 4 * fq;
#pragma unroll
        for (int ai = 0; ai < 2; ++ai)
#pragma unroll
            for (int m = 0; m < 4; ++m) { const int row = row0 + ai * HALF + m * 16; bf16_t* rowp = rp + (size_t)(ai * HALF + m * 16) * LDC;
                const int t = row & (SEQ - 1), pos = axis ? (t & 63) : (t >> 6);
                f32x4 cs0 = *(const f32x4*)(TAB + (pos * 32 + f0) * 2), cs1 = *(const f32x4*)(TAB + (pos * 32 + f0) * 2 + 4);
                if (row >= ML) { cs0 = (f32x4){1.f, 0.f, 1.f, 0.f}; cs1 = cs0; }
#pragma unroll
                for (int bj = 0; bj < 2; ++bj) { const f32x4 x1 = acc[ai][bj][m][0], x2 = acc[ai][bj][m][1];
                    u32x4 w;
                    w.x = cvt_pk_bf16(x1[0] * cs0[0] - x2[0] * cs0[1], x1[1] * cs0[2] - x2[1] * cs0[3]);
                    w.y = cvt_pk_bf16(x1[2] * cs1[0] - x2[2] * cs1[1], x1[3] * cs1[2] - x2[3] * cs1[3]);
                    w.z = cvt_pk_bf16(x2[0] * cs0[0] + x1[0] * cs0[1], x2[1] * cs0[2] + x1[1] * cs0[3]);
                    w.w = cvt_pk_bf16(x2[2] * cs1[0] + x1[2] * cs1[1], x2[3] * cs1[2] + x1[3] * cs1[3]);
                    *(u32x4*)(rowp + bj * HALF) = w; } }
    }
    __device__ __forceinline__ void operator()(const f32x4 (&acc)[2][2][4][2], const Unit& u, int wr, int wc, int fr, int fq) const {
        const int pn = u.pn; const int row0 = u.pm * BM + wr * 64 + fr, col0 = wc * 32 + 8 * fq;
        if (pn < 8) { bf16_t* base = (pn < 4 ? XR + pn * 256 : GR + (pn - 4) * 256) + col0; store<1024>(acc, base, row0); }
        else if (pn < 12) { store_rope<1024>(acc, Q + (pn - 8) * 256 + col0, row0, wc, fq); }
        else if (pn == 12) { store_rope<512>(acc, KV + col0, row0, wc, fq); }
        else if (pn == 13) { store<512>(acc, KV + 256 + col0, row0); }
        else { store<2048>(acc, GL + (pn - 14) * 256 + col0, row0); }
    }
};
struct EpiSwiGLU {
    static constexpr bool PERM = true;
    bf16_t* O;
    __device__ __forceinline__ void mid(f32x4 (&acc)[2][2][4][2], const Unit& u, int wr, int wc, int fr, int fq) const {}
    __device__ __forceinline__ void operator()(const f32x4 (&acc)[2][2][4][2], const Unit& u, int wr, int wc, int fr, int fq) const {
        const int row0 = u.pm * BM + wr * 64 + fr, col0 = u.pn * 128 + wc * 32 + 8 * fq;
#pragma unroll
        for (int ai = 0; ai < 2; ++ai)
#pragma unroll
            for (int m = 0; m < 4; ++m) { bf16_t* rowp = O + (size_t)(row0 + ai * HALF + m * 16) * DFF + col0;
                float r[8];
#pragma unroll
                for (int n = 0; n < 2; ++n)
#pragma unroll
                    for (int j = 0; j < 4; ++j) r[n * 4 + j] = siluf_(acc[ai][0][m][n][j]) * acc[ai][1][m][n][j];
                u32x4 w; w.x = cvt_pk_bf16(r[0], r[1]); w.y = cvt_pk_bf16(r[2], r[3]); w.z = cvt_pk_bf16(r[4], r[5]); w.w = cvt_pk_bf16(r[6], r[7]);
                *(u32x4*)rowp = w; }
    }
};
struct EpiMerge {
    static constexpr bool PERM = true;
    const bf16_t* GL; bf16_t* G; bf16_t* SL;
    __device__ __forceinline__ void mid(f32x4 (&acc)[2][2][4][2], const Unit& u, int wr, int wc, int fr, int fq) const {
        const int row0 = u.pm * BM + wr * 64 + fr, col0 = u.pn * BM + wc * 32 + 8 * fq;
#pragma unroll
        for (int ai = 0; ai < 2; ++ai)
#pragma unroll
            for (int m = 0; m < 4; ++m) { const bf16_t* gp = GL + (size_t)(row0 + ai * HALF + m * 16) * 2048 + col0;
#pragma unroll
                for (int bj = 0; bj < 2; ++bj) { const u32x4 la = *(const u32x4*)(gp + bj * HALF), lb = *(const u32x4*)(gp + 1024 + bj * HALF);
#pragma unroll
                    for (int n = 0; n < 2; ++n)
#pragma unroll
                        for (int j = 0; j < 4; ++j) { const int e = n * 4 + j; const unsigned wa = la[e >> 1], wb = lb[e >> 1];
                            const float a = (e & 1) ? bfhi(wa) : bflo(wa), b = (e & 1) ? bfhi(wb) : bflo(wb);
                            acc[ai][bj][m][n][j] *= (1.0f + __expf(-b)) * __builtin_amdgcn_rcpf(1.0f + __expf(-a)); }
                    asm volatile("" : "+v"(acc[ai][bj][m][0]), "+v"(acc[ai][bj][m][1]) :: "memory"); } }
    }
    __device__ __forceinline__ void operator()(const f32x4 (&acc)[2][2][4][2], const Unit& u, int wr, int wc, int fr, int fq) const {
        const int row0 = u.pm * BM + wr * 64 + fr, col0 = u.pn * BM + wc * 32 + 8 * fq;
        bf16_t* gout = u.slab < 0 ? G : SL + (size_t)u.slab * (1024 * 1024) - (size_t)ML * 1024;
#pragma unroll
        for (int ai = 0; ai < 2; ++ai)
#pragma unroll
            for (int m = 0; m < 4; ++m) { const size_t r = (size_t)(row0 + ai * HALF + m * 16);
#pragma unroll
                for (int bj = 0; bj < 2; ++bj) { const u32x4 lb = *(const u32x4*)(GL + r * 2048 + 1024 + col0 + bj * HALF); float o[8];
#pragma unroll
                    for (int n = 0; n < 2; ++n)
#pragma unroll
                        for (int j = 0; j < 4; ++j) { const int e = n * 4 + j; const unsigned wb = lb[e >> 1]; const float b = (e & 1) ? bfhi(wb) : bflo(wb);
                            o[e] = acc[ai][bj][m][n][j] * __builtin_amdgcn_rcpf(1.0f + __expf(-b)); }
                    u32x4 w; w.x = cvt_pk_bf16(o[0], o[1]); w.y = cvt_pk_bf16(o[2], o[3]); w.z = cvt_pk_bf16(o[4], o[5]); w.w = cvt_pk_bf16(o[6], o[7]);
                    *(u32x4*)(gout + r * 1024 + col0 + bj * HALF) = w; asm volatile("" ::: "memory"); } }
    }
};
struct EpiBf16 {
    static constexpr bool PERM = true;
    bf16_t* O; bf16_t* SL;
    __device__ __forceinline__ void mid(f32x4 (&acc)[2][2][4][2], const Unit& u, int wr, int wc, int fr, int fq) const {}
    __device__ __forceinline__ void operator()(const f32x4 (&acc)[2][2][4][2], const Unit& u, int wr, int wc, int fr, int fq) const {
        const int row0 = u.pm * BM + wr * 64 + fr, col0 = u.pn * BM + wc * 32 + 8 * fq;
        bf16_t* ob = u.slab < 0 ? O : SL + (size_t)u.slab * (1024 * 1024) - (size_t)ML * 1024;
#pragma unroll
        for (int ai = 0; ai < 2; ++ai)
#pragma unroll
            for (int m = 0; m < 4; ++m) { bf16_t* rowp = ob + (size_t)(row0 + ai * HALF + m * 16) * 1024 + col0;
#pragma unroll
                for (int bj = 0; bj < 2; ++bj) { const f32x4 v0 = acc[ai][bj][m][0], v1 = acc[ai][bj][m][1];
                    u32x4 w; w.x = cvt_pk_bf16(v0[0], v0[1]); w.y = cvt_pk_bf16(v0[2], v0[3]); w.z = cvt_pk_bf16(v1[0], v1[1]); w.w = cvt_pk_bf16(v1[2], v1[3]);
                    *(u32x4*)(rowp + bj * HALF) = w; } }
    }
};
struct EpiF32 {
    static constexpr bool PERM = false;
    float* O;
    __device__ __forceinline__ void mid(f32x4 (&acc)[2][2][4][2], const Unit& u, int wr, int wc, int fr, int fq) const {}
    __device__ __forceinline__ void operator()(const f32x4 (&acc)[2][2][4][2], const Unit& u, int wr, int wc, int fr, int fq) const {
        const int row0 = u.pm * BM + wr * 64 + fr, col0 = u.pn * BM + wc * 32 + 4 * fq;
#pragma unroll
        for (int ai = 0; ai < 2; ++ai)
#pragma unroll
            for (int m = 0; m < 4; ++m) { float* rowp = O + (size_t)(row0 + ai * HALF + m * 16) * 1024 + col0;
#pragma unroll
                for (int bj = 0; bj < 2; ++bj)
#pragma unroll
                    for (int n = 0; n < 2; ++n) *(f32x4*)(rowp + bj * HALF + n * 16) = acc[ai][bj][m][n]; }
    }
};
}

namespace att {
constexpr float SCALE = 0.088388347648318440f;
constexpr float THR = 8.f;
constexpr int SHM_V = 64 * 128 * 2, SHM_K = 64 * 128 * 2;
#define KSWZ(row, colB) ((row) * 256 + ((colB) ^ (((row) & 7) << 4)))
#define SBAR() __builtin_amdgcn_sched_barrier(0)
__device__ __forceinline__ int crow(int r, int hi) { return (r & 3) + 8 * (r >> 2) + 4 * hi; }
__device__ __forceinline__ void partialSM(f32x16& p0, f32x16& p1, float& m_reg, float& mn, float& alpha) {
    constexpr float C = SCALE * 1.4426950408889634f;
    float pmax = p0[0];
#pragma unroll
    for (int r = 1; r < 16; ++r) pmax = fmaxf(pmax, p0[r]);
#pragma unroll
    for (int r = 0; r < 16; ++r) pmax = fmaxf(pmax, p1[r]);
    { auto rr = __builtin_amdgcn_permlane32_swap(__float_as_uint(pmax), __float_as_uint(pmax), false, false);
      pmax = fmaxf(__uint_as_float(rr[0]), __uint_as_float(rr[1])); }
    if (__builtin_expect(__all(pmax - m_reg <= THR / SCALE), 1)) { mn = m_reg; alpha = 1.f; }
    else { mn = fmaxf(m_reg, pmax); alpha = __builtin_amdgcn_exp2f((m_reg - mn) * C); m_reg = mn; }
    const float mnC = -mn * C;
#pragma unroll
    for (int r = 0; r < 16; ++r) p0[r] = fmaf(p0[r], C, mnC);
#pragma unroll
    for (int r = 0; r < 16; ++r) p1[r] = fmaf(p1[r], C, mnC);
#pragma unroll
    for (int r = 0; r < 16; ++r) p0[r] = __builtin_amdgcn_exp2f(p0[r]);
}
__device__ __forceinline__ void finishSM(f32x16& p0, f32x16& p1, float alpha, float& l_reg, bf16x8& pa0, bf16x8& pa1, bf16x8& pa2, bf16x8& pa3) {
#pragma unroll
    for (int r = 0; r < 16; ++r) p1[r] = __builtin_amdgcn_exp2f(p1[r]);
    float ps = 0;
#pragma unroll
    for (int r = 0; r < 16; ++r) ps += p0[r];
#pragma unroll
    for (int r = 0; r < 16; ++r) ps += p1[r];
    { auto rr = __builtin_amdgcn_permlane32_swap(__float_as_uint(ps), __float_as_uint(ps), false, false);
      ps = __uint_as_float(rr[0]) + __uint_as_float(rr[1]); }
    l_reg = l_reg * alpha + ps;
#define PK4(P, BASE, OUT) do { unsigned a0 = cvt_pk_bf16(P[BASE + 0], P[BASE + 1]), a1 = cvt_pk_bf16(P[BASE + 2], P[BASE + 3]);   \
    unsigned b0 = cvt_pk_bf16(P[BASE + 4], P[BASE + 5]), b1 = cvt_pk_bf16(P[BASE + 6], P[BASE + 7]);                              \
    auto r0 = __builtin_amdgcn_permlane32_swap(a0, b0, false, false); auto r1 = __builtin_amdgcn_permlane32_swap(a1, b1, false, false); \
    u32x4 w = {r0[0], r1[0], r0[1], r1[1]}; OUT = *reinterpret_cast<bf16x8*>(&w); } while (0)
    PK4(p0, 0, pa0); PK4(p0, 8, pa1); PK4(p1, 0, pa2); PK4(p1, 8, pa3);
#undef PK4
}
__device__ __forceinline__ void qkt(f32x16& p0, f32x16& p1, const char* Ks, const bf16x8* qr, int r32, int hi) {
    p0 = f32x16{}; p1 = f32x16{};
#pragma unroll
    for (int d0 = 0; d0 < 8; ++d0) { const int cb = (d0 * 16 + hi * 8) * 2;
        const bf16x8 b0 = *reinterpret_cast<const bf16x8*>(Ks + KSWZ(r32, cb));
        const bf16x8 b1 = *reinterpret_cast<const bf16x8*>(Ks + KSWZ(32 + r32, cb));
        p0 = __builtin_amdgcn_mfma_f32_32x32x16_bf16(b0, qr[d0], p0, 0, 0, 0);
        p1 = __builtin_amdgcn_mfma_f32_32x32x16_bf16(b1, qr[d0], p1, 0, 0, 0); }
}
__device__ __forceinline__ int v_st(int k, int c) { const int kk = (k & ~0xC) | ((k & 4) << 1) | ((k & 8) >> 1); return ((kk >> 3) * 4 + (c >> 5)) * 512 + ((kk & 7) * 32 + (c & 31)) * 2; }
__device__ __forceinline__ int v_rd_base(int lane) { return ((lane & 3) << 3) | (((lane >> 2) & 3) << 6) | (((lane >> 4) & 1) << 5) | (((lane >> 5) & 1) << 8); }
constexpr int v_rd_off(int d0, int ks, int half) { return d0 * 512 + ks * 4096 + half * 2048; }
template <int OFF> __device__ __forceinline__ s16x4 tr_read(int vb) {
    s16x4 r; asm volatile("ds_read_b64_tr_b16 %0, %1 offset:%2" : "=&v"(r) : "v"(vb), "i"(OFF) : "memory"); return r;
}
template <int D0> __device__ __forceinline__ void pv_one(f32x16& od, int vb, bf16x8 pa0, bf16x8 pa1, bf16x8 pa2, bf16x8 pa3) {
    const s16x4 l0 = tr_read<v_rd_off(D0, 0, 0)>(vb), h0 = tr_read<v_rd_off(D0, 0, 1)>(vb), l1 = tr_read<v_rd_off(D0, 1, 0)>(vb), h1 = tr_read<v_rd_off(D0, 1, 1)>(vb);
    const s16x4 l2 = tr_read<v_rd_off(D0, 2, 0)>(vb), h2 = tr_read<v_rd_off(D0, 2, 1)>(vb), l3 = tr_read<v_rd_off(D0, 3, 0)>(vb), h3 = tr_read<v_rd_off(D0, 3, 1)>(vb);
    asm volatile("s_waitcnt lgkmcnt(0)" ::: "memory"); SBAR();
#define PK(L, H) (bf16x8){L[0], L[1], L[2], L[3], H[0], H[1], H[2], H[3]}
    od = __builtin_amdgcn_mfma_f32_32x32x16_bf16(pa0, PK(l0, h0), od, 0, 0, 0);
    od = __builtin_amdgcn_mfma_f32_32x32x16_bf16(pa1, PK(l1, h1), od, 0, 0, 0);
    od = __builtin_amdgcn_mfma_f32_32x32x16_bf16(pa2, PK(l2, h2), od, 0, 0, 0);
    od = __builtin_amdgcn_mfma_f32_32x32x16_bf16(pa3, PK(l3, h3), od, 0, 0, 0);
#undef PK
}

__device__ __forceinline__ void attn_unit(char* lds, const int tid, const bf16_t* Qb, bf16_t* Ob, const bf16_t* KVb, int qrow0, int t0, int b, int kvh, const float* sink_l) {
    const int wid = tid >> 6, lane = tid & 63, r32 = lane & 31, hi = lane >> 5;
    char* V_lds = lds; char* K_lds = lds + 2 * SHM_V;
    float* ws = (float*)(lds + 2 * SHM_V + 2 * SHM_K) + wid * 64; float* li_l = ws; float* al_l = ws + 32;
    const int h = kvh * 4 + (wid >> 1);
    const int qoff = (wid & 1) * 32;
    bf16x8 qr[8];
    { const bf16_t* Qw = Qb + (size_t)(qrow0 + qoff + r32) * 1024 + h * 128 + hi * 8;
#pragma unroll
      for (int d0 = 0; d0 < 8; ++d0) qr[d0] = *reinterpret_cast<const bf16x8*>(Qw + d0 * 16); }
    float m_reg = sink_l[h] / SCALE, l_reg = 1.f;
    f32x16 o[4] = {};
    int ks_first = 0, nbt = 0;
    if (t0 >= 0) { ks_first = t0 - 128 < 0 ? 0 : t0 - 128; const int ke = t0 + 192 > SEQ ? SEQ : t0 + 192; nbt = (ke - ks_first) >> 6; }
    const int NT = nbt + 4;
    const int sr = tid >> 4, sc = (tid & 15) * 8, vst0 = v_st(sr, sc), vst1 = v_st(32 + sr, sc);
    const int vb0 = (int)(uintptr_t)V_lds + v_rd_base(lane);
    bf16x8 vs0, vs1, ks0, ks1;
#define TROW(j) ((j) < nbt ? b * SEQ + ks_first + 64 * (j) : ML + b * CTX + 64 * ((j) - nbt))
#define SLOAD(j) do { const bf16_t* kp = KVb + (size_t)(TROW(j) + sr) * 512 + kvh * 128 + sc; \
    ks0 = *reinterpret_cast<const bf16x8*>(kp); ks1 = *reinterpret_cast<const bf16x8*>(kp + 32 * 512); \
    vs0 = *reinterpret_cast<const bf16x8*>(kp + 256); vs1 = *reinterpret_cast<const bf16x8*>(kp + 256 + 32 * 512); } while (0)
#define SWRITE(bu) do { *(bf16x8*)(V_lds + (bu) * SHM_V + vst0) = vs0; *(bf16x8*)(V_lds + (bu) * SHM_V + vst1) = vs1; const int kc = sc * 2; \
    *(bf16x8*)(K_lds + (bu) * SHM_K + KSWZ(sr, kc)) = ks0; *(bf16x8*)(K_lds + (bu) * SHM_K + KSWZ(32 + sr, kc)) = ks1; } while (0)
    SLOAD(0); SWRITE(0); __syncthreads();
    const int qpos = t0 + qoff + r32;
    for (int j = 0; j < NT; ++j) {
        const int bu = j & 1;
        f32x16 p0, p1; float mn, alpha; bf16x8 pa0, pa1, pa2, pa3;
        qkt(p0, p1, K_lds + bu * SHM_K, qr, r32, hi);
        const int kw = ks_first + 64 * j - (t0 + qoff);
        if (j < nbt && (kw + 63 > 128 || kw < -97)) { const int kb = ks_first + 64 * j - qpos;
#pragma unroll
            for (int r = 0; r < 16; ++r) { const int d0 = kb + crow(r, hi), d1 = d0 + 32;
                if (d0 > 128 || d0 < -128) p0[r] = -1e30f; if (d1 > 128 || d1 < -128) p1[r] = -1e30f; } }
        partialSM(p0, p1, m_reg, mn, alpha);
        if (__any(alpha < 1.f)) { if (hi == 0) al_l[r32] = alpha; asm volatile("s_waitcnt lgkmcnt(0)" ::: "memory");
#pragma unroll
            for (int d = 0; d < 4; ++d)
#pragma unroll
                for (int r = 0; r < 16; ++r) o[d][r] *= al_l[crow(r, hi)]; }
        finishSM(p0, p1, alpha, l_reg, pa0, pa1, pa2, pa3); SBAR();
        if (j + 1 < NT) SLOAD(j + 1);
        SBAR();
        const int vb = vb0 + bu * SHM_V;
        pv_one<0>(o[0], vb, pa0, pa1, pa2, pa3); pv_one<1>(o[1], vb, pa0, pa1, pa2, pa3); pv_one<2>(o[2], vb, pa0, pa1, pa2, pa3); pv_one<3>(o[3], vb, pa0, pa1, pa2, pa3);
        if (j + 1 < NT) SWRITE(bu ^ 1);
        __syncthreads();
    }
    if (hi == 0) li_l[r32] = l_reg; asm volatile("s_waitcnt lgkmcnt(0)" ::: "memory");
    bf16_t* ost = (bf16_t*)(lds + 2 * SHM_V + 2 * SHM_K + 2048) + wid * (32 * 136);
#pragma unroll
    for (int r = 0; r < 16; ++r) { const int orow = crow(r, hi); const float rl = __builtin_amdgcn_rcpf(li_l[orow]);
#pragma unroll
        for (int d0 = 0; d0 < 4; ++d0) { const unsigned w = cvt_pk_bf16(o[d0][r] * rl, 0.f); ost[orow * 136 + d0 * 32 + r32] = (bf16_t)(w & 0xffffu); } }
    asm volatile("s_waitcnt lgkmcnt(0)" ::: "memory"); __builtin_amdgcn_wave_barrier();
    { const int col = (lane & 15) * 8;
#pragma unroll
      for (int i = 0; i < 8; ++i) { const int orow = (lane >> 4) + 4 * i;
          *reinterpret_cast<u32x4*>(Ob + (size_t)(qrow0 + qoff + orow) * 1024 + h * 128 + col) = *reinterpret_cast<const u32x4*>(ost + orow * 136 + col); } }
    __builtin_amdgcn_wave_barrier();
#undef TROW
#undef SLOAD
#undef SWRITE
}
}

#define XB_TMO      128
#define XB_XCNT(j)  (256  + 64 * (j))
#define XB_XSUB(j)  (1280 + 64 * (j))
#define XB_XGEN(j)  (2304 + 64 * (j))
#define XB_TOP      3328
#define XB_TOPGEN   3392
#define XCD_BAR_WORDS 3456
#define XB_SPIN_CAP (1u << 18)
__device__ __forceinline__ unsigned xb_ld(unsigned* p)              { return __hip_atomic_load(p, __ATOMIC_RELAXED, __HIP_MEMORY_SCOPE_AGENT); }
__device__ __forceinline__ unsigned xb_add(unsigned* p, unsigned v) { return __hip_atomic_fetch_add(p, v, __ATOMIC_RELAXED, __HIP_MEMORY_SCOPE_AGENT); }
__device__ __forceinline__ unsigned xb_xcc_id() { return (unsigned)__builtin_amdgcn_s_getreg((3 << 11) | 20) & 0xFu; }
#define XB_SPIN(cond, bar) do { unsigned _sp = 0; while (cond) { __builtin_amdgcn_s_sleep(1); \
    if ((++_sp & 255u) == 0u) { if (xb_ld(&(bar)[XB_TMO])) break; if (_sp > XB_SPIN_CAP) { atomicAdd(&(bar)[XB_TMO], 1u); break; } } } } while (0)
struct XcdBarrier { unsigned* bar; unsigned x; volatile LAS unsigned* st; };
__device__ __forceinline__ XcdBarrier xcd_barrier_post(unsigned* bar, volatile LAS unsigned* st) {
    XcdBarrier b; b.bar = bar; b.x = xb_xcc_id(); b.st = st;
    if (threadIdx.x == 0) (void)xb_add(&bar[XB_XCNT(b.x)], 1u);
    return b;
}
__device__ __forceinline__ void xcd_barrier_complete(unsigned* bar, unsigned x, unsigned& nloc, unsigned& nx) {
    const unsigned G = gridDim.x * gridDim.y * gridDim.z;
    unsigned sum, cnt, mine, sp = 0u;
    for (;;) {
        sum = 0u; cnt = 0u; mine = 0u;
#pragma unroll
        for (unsigned j = 0; j < 16; ++j) { const unsigned c = xb_ld(&bar[XB_XCNT(j)]); sum += c; cnt += (c > 0u) ? 1u : 0u; mine = (j == x) ? c : mine; }
        if (sum == G) break;
        __builtin_amdgcn_s_sleep(1);
        if ((++sp & 255u) == 0u) { if (xb_ld(&bar[XB_TMO])) break; if (sp > XB_SPIN_CAP) { atomicAdd(&bar[XB_TMO], 1u); break; } }
    }
    nloc = mine > 0u ? mine : 1u; nx = cnt > 0u ? cnt : 1u;
}
__device__ __forceinline__ void xcd_barrier(const XcdBarrier& b) {
    asm volatile("s_waitcnt vmcnt(0)" ::: "memory");
    __syncthreads();
    if (threadIdx.x == 0) {
        unsigned* bar = b.bar;
        __builtin_amdgcn_s_waitcnt(0);
        unsigned nloc = b.st[0], nx = b.st[1];
        if (nloc == 0u) { xcd_barrier_complete(bar, b.x, nloc, nx); b.st[0] = nloc; b.st[1] = nx; }
        const unsigned old = xb_add(&bar[XB_XSUB(b.x)], 1u);
        const unsigned gen = old / nloc;
        if (old + 1u == (gen + 1u) * nloc) {
            __builtin_amdgcn_fence(__ATOMIC_RELEASE, "agent");
            asm volatile("s_waitcnt vmcnt(0)" ::: "memory");
            const unsigned og = xb_add(&bar[XB_TOP], 1u);
            const unsigned tg = og / nx;
            if (og + 1u == (tg + 1u) * nx) xb_add(&bar[XB_TOPGEN], 1u);
            else XB_SPIN(xb_ld(&bar[XB_TOPGEN]) == tg, bar);
            __builtin_amdgcn_fence(__ATOMIC_ACQUIRE, "agent");
            xb_add(&bar[XB_XGEN(b.x)], 1u);
            asm volatile("s_waitcnt vmcnt(0)" ::: "memory");
        } else {
            XB_SPIN(xb_ld(&bar[XB_XGEN(b.x)]) == gen, bar);
            __builtin_amdgcn_fence(__ATOMIC_ACQUIRE, "agent");
            asm volatile("s_waitcnt vmcnt(0)" ::: "memory");
        }
    }
    __syncthreads();
}

struct Params { const float* in[24]; float* out; unsigned char* ws; int ph_lo, ph_hi; };

struct Ctx {
    const Params* p; LAS unsigned char* lds; char* ldsg; int tid, lane, wave, G, bid;
};

__device__ __forceinline__ int rope_perm_col(int c) {
    const int d = c & 63, n = d >> 5, f = d & 31; return (c & ~63) + 32 * (f >> 4) + 8 * ((f >> 2) & 3) + 4 * n + (f & 3);
}
struct TItem { const float* W; bf16_t* WT; int ldw, ldt, k0, n0, drow0, rperm; float scale; };
__device__ __forceinline__ void titem_load(const TItem& t, float (&tv)[32], int lane) {
#pragma unroll
    for (int i = 0; i < 32; ++i) tv[i] = t.scale * t.W[(size_t)(t.k0 + i) * t.ldw + t.n0 + lane];
}
__device__ __forceinline__ void titem_store(const TItem& t, const float (&tv)[32], LAS float* scr, int lane) {
#pragma unroll
    for (int i = 0; i < 32; ++i) scr[i * 65 + lane] = tv[i];
    asm volatile("s_waitcnt lgkmcnt(0)" ::: "memory");
    const int c = lane & 3;
#pragma unroll
    for (int j = 0; j < 4; ++j) { const int n = (lane >> 2) + 16 * j; const LAS float* s = scr + (8 * c) * 65 + n;
        u32x4 o; o.x = cvt_pk_bf16(s[0 * 65], s[1 * 65]); o.y = cvt_pk_bf16(s[2 * 65], s[3 * 65]); o.z = cvt_pk_bf16(s[4 * 65], s[5 * 65]); o.w = cvt_pk_bf16(s[6 * 65], s[7 * 65]);
        const int drow = t.rperm ? rope_perm_col(t.drow0 + n) : t.drow0 + n;
        *(u32x4*)(t.WT + (size_t)drow * t.ldt + t.k0 + 8 * c) = o; }
    asm volatile("s_waitcnt lgkmcnt(0)" ::: "memory");
}
constexpr int WA_ITEMS = 32 * 88 + 3 * 32 * 16 + 256;
__device__ __forceinline__ TItem decode_WA(const Params& P, int l, int it) {
    unsigned char* W = P.ws + OFF_W; TItem t; constexpr int I_IN = 32 * 88, I_SQ = 32 * 16;
    int r = it; t.scale = 1.0f;
    if (r < I_IN) { const int kb = r / 88, nb = r % 88; t.W = P.in[10] + (size_t)l * 1024 * INW; t.ldw = INW; t.k0 = kb * 32; t.n0 = nb * 64; t.WT = (bf16_t*)(W + W_WIN); t.ldt = 1024; t.drow0 = nb * 64; t.rperm = (nb >= 32 && nb < 52) ? 1 : 0; return t; }
    r -= I_IN;
    if (r < 3 * I_SQ) { const int which = r / I_SQ; r %= I_SQ; const int kb = r / 16, nb = r % 16; t.W = P.in[19 + which] + (size_t)l * 1024 * 1024; t.ldw = 1024; t.k0 = kb * 32; t.n0 = nb * 64;
        t.WT = (bf16_t*)(W + (which == 0 ? W_WOR : which == 1 ? W_WOA : W_WOUT)); t.ldt = 1024; t.drow0 = nb * 64; t.rperm = 0; return t; }
    r -= 3 * I_SQ;
    { const int mat = r >> 3, sub = r & 7, kb = sub >> 1, nb = sub & 1; const int dir = mat >> 4, g = (mat >> 3) & 1, blk = mat & 7;
      t.W = P.in[g ? 15 : 13] + ((size_t)(l * 2 + dir) * 8 + blk) * 128 * 128; t.ldw = 128; t.k0 = kb * 32; t.n0 = nb * 64; t.WT = (bf16_t*)(W + W_WG) + (size_t)mat * 128 * 128; t.ldt = 128; t.drow0 = nb * 64; t.rperm = 0; t.scale = -1.4426950408889634f; return t; }
}
constexpr int WF_ITEMS = 32 * 88 + 88 * 16;
__device__ __forceinline__ TItem decode_WF(const Params& P, int l, int it) {
    unsigned char* W = P.ws + OFF_W; TItem t; constexpr int I_FI = 32 * 88;
    int r = it; t.rperm = 0; t.scale = 1.0f;
    if (r < I_FI) { const int kb = r / 88, nb = r % 88; const int n0 = nb * 64; const int up = n0 >= DFF ? 1 : 0, nn = n0 - up * DFF;
        t.W = P.in[22] + (size_t)l * 1024 * INW; t.ldw = INW; t.k0 = kb * 32; t.n0 = n0; t.WT = (bf16_t*)(W + W_WFI); t.ldt = 1024; t.drow0 = 256 * (nn >> 7) + 128 * up + (nn & 127); return t; }
    r -= I_FI;
    { const int kb = r / 16, nb = r % 16; t.W = P.in[23] + (size_t)l * DFF * 1024; t.ldw = 1024; t.k0 = kb * 32; t.n0 = nb * 64; t.WT = (bf16_t*)(W + W_WFO); t.ldt = DFF; t.drow0 = nb * 64; return t; }
}
template <bool FFN>
__device__ __forceinline__ void convert_weights(const Ctx& F, int l) {
    const Params& P = *F.p;
    LAS float* scr = (LAS float*)(F.lds + F.wave * 16384);
    const int gw = F.bid * 8 + F.wave, NGW = F.G * 8; constexpr int NIT = FFN ? WF_ITEMS : WA_ITEMS;
    if (gw >= NIT) return;
    float tva[32], tvb[32];
    TItem ca = FFN ? decode_WF(P, l, gw) : decode_WA(P, l, gw), cb = ca;
    titem_load(ca, tva, F.lane);
    for (int it = gw; it < NIT; it += 2 * NGW) {
        const bool hb = it + NGW < NIT;
        if (hb) { cb = FFN ? decode_WF(P, l, it + NGW) : decode_WA(P, l, it + NGW); titem_load(cb, tvb, F.lane); }
        titem_store(ca, tva, scr, F.lane);
        if (!hb) break;
        const bool ha = it + 2 * NGW < NIT;
        if (ha) { ca = FFN ? decode_WF(P, l, it + 2 * NGW) : decode_WA(P, l, it + 2 * NGW); titem_load(ca, tva, F.lane); }
        titem_store(cb, tvb, scr, F.lane);
        if (!ha) break;
    }
}
__device__ __forceinline__ void convert_WA(const Ctx& F, int l) { convert_weights<false>(F, l); }
__device__ __forceinline__ void convert_WF(const Ctx& F, int l) { convert_weights<true>(F, l); }

__device__ __forceinline__ void mod_phase(const Ctx& F) {
    const Params& P = *F.p; float* MOD = (float*)(P.ws + OFF_MOD);
    LAS float* sv = (LAS float*)F.lds;
    LAS float* red = (LAS float*)(F.lds + 32768);
    if (F.bid >= 192) return;
    for (int i = F.tid; i < 1024; i += 512) {
#pragma unroll
        for (int r = 0; r < 4; ++r) sv[i * 8 + r] = siluf_(P.in[1][r * 1024 + i]);
        sv[i * 8 + 4] = siluf_(P.in[3][i]); sv[i * 8 + 5] = 0.f; sv[i * 8 + 6] = 0.f; sv[i * 8 + 7] = 0.f; }
    __syncthreads();
    for (int it = F.bid; it < 192; it += F.G) {
        const int l = it / 96, n0 = (it % 96) * 64;
        const float* Wm = P.in[4] + (size_t)l * 1024 * 6144 + n0 + F.lane;
        float a0 = 0, a1 = 0, a2 = 0, a3 = 0, a4 = 0;
        const int kb = F.wave * 128;
#pragma unroll 32
        for (int k = 0; k < 128; ++k) { const float w = Wm[(size_t)(kb + k) * 6144]; const LAS float* s = sv + (kb + k) * 8;
            const f32x4 s4 = *(const LAS f32x4*)s; a0 += s4[0] * w; a1 += s4[1] * w; a2 += s4[2] * w; a3 += s4[3] * w; a4 += s[4] * w; }
        red[(F.wave * 5 + 0) * 64 + F.lane] = a0; red[(F.wave * 5 + 1) * 64 + F.lane] = a1; red[(F.wave * 5 + 2) * 64 + F.lane] = a2;
        red[(F.wave * 5 + 3) * 64 + F.lane] = a3; red[(F.wave * 5 + 4) * 64 + F.lane] = a4;
        __syncthreads();
        if (F.wave < 5) { float s = 0;
#pragma unroll
            for (int w = 0; w < 8; ++w) s += red[(w * 5 + F.wave) * 64 + F.lane];
            MOD[(size_t)(l * 5 + F.wave) * 6144 + n0 + F.lane] = s + P.in[5][l * 6144 + n0 + F.lane]; }
        __syncthreads();
    }
}

template <bool BR, bool WH>
__device__ __forceinline__ void norm_phase(const Ctx& F, int nrows, const float* xin_lat, const float* xin_ctx, const bf16_t* branch, const bf16_t* slabs, const float* g_post, const float* mod_g, int gate_off,
                                           float* xout_lat, float* xout_ctx, const float* g_pre, const float* mod_h, int sc_off, int sh_off, bf16_t* Hout) {
    const int gw = F.bid * 8 + F.wave, NGW = F.G * 8, lane = F.lane;
    f32x4 xc[4], xn[4]; u32x2 bc[4], bn[4];
#define NORM_LOAD(row_, X_, B_) do { const int r__ = (row_); const float* xr = r__ < ML ? xin_lat + (size_t)r__ * 1024 : xin_ctx + (size_t)(r__ - ML) * 1024; \
        _Pragma("unroll") for (int j = 0; j < 4; ++j) X_[j] = *(const f32x4*)(xr + 4 * lane + 256 * j); \
        if (BR) { if (slabs != nullptr && r__ >= ML) { _Pragma("unroll") for (int j = 0; j < 4; ++j) { f32x4 a = {0.f, 0.f, 0.f, 0.f}; \
                      _Pragma("unroll") for (int sl = 0; sl < 4; ++sl) { const u32x2 bw = *(const u32x2*)(slabs + (size_t)sl * (1024 * 1024) + (size_t)(r__ - ML) * 1024 + 4 * lane + 256 * j); a = a + (f32x4){bflo(bw.x), bfhi(bw.x), bflo(bw.y), bfhi(bw.y)}; } \
                      B_[j].x = cvt_pk_bf16(a[0], a[1]); B_[j].y = cvt_pk_bf16(a[2], a[3]); } } \
                  else { _Pragma("unroll") for (int j = 0; j < 4; ++j) B_[j] = *(const u32x2*)(branch + (size_t)r__ * 1024 + 4 * lane + 256 * j); } } } while (0)
    if (gw >= nrows) return;
    NORM_LOAD(gw, xc, bc);
    for (int row = gw; row < nrows; row += NGW) {
        const bool hn = row + NGW < nrows;
        if (hn) NORM_LOAD(row + NGW, xn, bn);
        const int mrow = row < ML ? (row >> 12) : 4;
        f32x4 x[4];
#pragma unroll
        for (int j = 0; j < 4; ++j) x[j] = xc[j];
        if (BR) {
            f32x4 m[4]; float s = 0.f;
#pragma unroll
            for (int j = 0; j < 4; ++j) { m[j] = (f32x4){bflo(bc[j].x), bfhi(bc[j].x), bflo(bc[j].y), bfhi(bc[j].y)};
                s += (m[j][0] * m[j][0] + m[j][1] * m[j][1]) + (m[j][2] * m[j][2] + m[j][3] * m[j][3]); }
            const float rs = rsqrtf(wave_sum(s, lane) * (1.f / 1024.f) + EPS);
            float* xo = row < ML ? xout_lat + (size_t)row * 1024 : xout_ctx + (size_t)(row - ML) * 1024;
#pragma unroll
            for (int j = 0; j < 4; ++j) { const f32x4 gp = *(const f32x4*)(g_post + 4 * lane + 256 * j), ga = *(const f32x4*)(mod_g + (size_t)mrow * 6144 + gate_off + 4 * lane + 256 * j);
                x[j] = x[j] + ga * ((m[j] * rs) * gp); *(f32x4*)(xo + 4 * lane + 256 * j) = x[j]; }
        }
        if (WH) {
            float s = 0.f;
#pragma unroll
            for (int j = 0; j < 4; ++j) s += (x[j][0] * x[j][0] + x[j][1] * x[j][1]) + (x[j][2] * x[j][2] + x[j][3] * x[j][3]);
            const float rs = rsqrtf(wave_sum(s, lane) * (1.f / 1024.f) + EPS);
#pragma unroll
            for (int j = 0; j < 4; ++j) { const f32x4 gp = *(const f32x4*)(g_pre + 4 * lane + 256 * j), sc = *(const f32x4*)(mod_h + (size_t)mrow * 6144 + sc_off + 4 * lane + 256 * j),
                    sh = *(const f32x4*)(mod_h + (size_t)mrow * 6144 + sh_off + 4 * lane + 256 * j);
                const f32x4 hv = ((x[j] * rs) * gp) * (sc + 1.0f) + sh;
                u32x2 w; w.x = cvt_pk_bf16(hv[0], hv[1]); w.y = cvt_pk_bf16(hv[2], hv[3]);
                *(u32x2*)(Hout + (size_t)row * 1024 + 4 * lane + 256 * j) = w; }
        }
        if (!hn) break;
#pragma unroll
        for (int j = 0; j < 4; ++j) { xc[j] = xn[j]; bc[j] = bn[j]; }
    }
#undef NORM_LOAD
}

__device__ __forceinline__ void rope_phase(const Ctx& F, bf16_t* Qb, bf16_t* KVb) {
    const int gw = F.bid * 8 + F.wave, NGW = F.G * 8, lane = F.lane;
    const int axis = lane >> 5, f = lane & 31;
    const float inv = exp2f(-(float)f * (13.287712379549449f / 32.0f));
    for (int row = gw; row < ML; row += NGW) {
        const int t = row & (SEQ - 1); const int pos = axis ? (t & 63) : (t >> 6);
        float sn, cs; sincosf((float)pos * inv, &sn, &cs);
        bf16_t* q = Qb + (size_t)row * 1024 + axis * 64 + f;
#pragma unroll
        for (int h = 0; h < 8; ++h) { const float x1 = bf2f(q[h * 128]), x2 = bf2f(q[h * 128 + 32]);
            const unsigned w = cvt_pk_bf16(x1 * cs - x2 * sn, x2 * cs + x1 * sn); q[h * 128] = (bf16_t)(w & 0xffff); q[h * 128 + 32] = (bf16_t)(w >> 16); }
        bf16_t* k = KVb + (size_t)row * 512 + axis * 64 + f;
#pragma unroll
        for (int h = 0; h < 2; ++h) { const float x1 = bf2f(k[h * 128]), x2 = bf2f(k[h * 128 + 32]);
            const unsigned w = cvt_pk_bf16(x1 * cs - x2 * sn, x2 * cs + x1 * sn); k[h * 128] = (bf16_t)(w & 0xffff); k[h * 128 + 32] = (bf16_t)(w >> 16); }
    }
}

constexpr int XT_LD = 136;
constexpr int RG_XT_BYTES = 64 * XT_LD * 2;
constexpr int RG_CW_OFF = RG_XT_BYTES, RG_CW_BYTES = 3072;
constexpr int RG_SC_OFF = RG_CW_OFF + RG_CW_BYTES;
constexpr int RG_SC_BYTES = 16640 + 1152;
template <int PASS>
__device__ __forceinline__ void rglru_phase(const Ctx& F, int l, const bf16_t* XRb, bf16_t* GRb) {
    const Params& P = *F.p;
    const int tid = F.tid, lane = F.lane, wave = F.wave;
    LAS bf16_t* XT = (LAS bf16_t*)F.lds;
    LAS float* CW = (LAS float*)(F.lds + RG_CW_OFF);
    LAS float* SCF = (LAS float*)(F.lds + RG_SC_OFF + wave * RG_SC_BYTES);
    LAS f32x2* AB = (LAS f32x2*)SCF;
    LAS float* CAR = (LAS float*)(F.lds + RG_SC_OFF + wave * RG_SC_BYTES + 16640);
    f32x2* AGG = (f32x2*)(P.ws + OFF_AGG);
    const bf16_t* WgT = (const bf16_t*)(P.ws + OFF_W + W_WG);
    const float* convw = P.in[11] + (size_t)l * 4 * 1024; const float* convb = P.in[12] + (size_t)l * 1024;
    const int cw = wave * 16, l15 = lane & 15, l4 = lane >> 4;
    const int tt = tid >> 3, cs = (tid & 7) * 16;
    for (int su = F.bid; su < 256; su += F.G) {
        const int pair = su >> 3, rg = su & 7, b = pair >> 3, blk = pair & 7;
        const int c0 = rg < 4 ? 9 * rg : 36 + 8 * (rg - 4), c1 = rg < 3 ? 9 * (rg + 1) : 36 + 8 * (rg - 3);
        __syncthreads();
        for (int i = tid; i < 640; i += 512) CW[i] = i < 512 ? convw[(i >> 7) * 1024 + blk * 128 + (i & 127)] : convb[blk * 128 + (i - 512)];
        bf16x8 Bf[4][4];
#pragma unroll
        for (int gt = 0; gt < 4; ++gt)
#pragma unroll
            for (int ks = 0; ks < 4; ++ks) Bf[gt][ks] = *(const bf16x8*)(WgT + ((size_t)(gt * 8 + blk) * 128 + cw + l15) * 128 + ks * 32 + 8 * l4);
        const int ch = blk * 128 + cw + l15;
        float nba[2], nbx[2], cl2[2];
#pragma unroll
        for (int d = 0; d < 2; ++d) { nba[d] = -1.4426950408889634f * P.in[14][(l * 2 + d) * 1024 + ch]; nbx[d] = -1.4426950408889634f * P.in[16][(l * 2 + d) * 1024 + ch];
            cl2[d] = -8.0f * 1.4426950408889634f * log1pf(__expf(-P.in[17][(l * 2 + d) * 1024 + ch])); }
        if (PASS == 2) {
#pragma unroll 1
            for (int d = 0; d < 2; ++d) {
                __builtin_amdgcn_wave_barrier();
                for (int k = l4; k < NCH; k += 4) AB[k * 16 + l15] = AGG[((size_t)(b * 2 + d) * NCH + k) * 1024 + ch];
                asm volatile("s_waitcnt vmcnt(0) lgkmcnt(0)" ::: "memory"); __builtin_amdgcn_wave_barrier();
                if (lane < 16) { float h = 0.f;
#pragma unroll 4
                    for (int q = 0; q < NCH; ++q) { const int c = d ? (q < 4 ? 3 - q : 71 - q) : q;
                        if (c >= c0 && c < c1) CAR[(d * 9 + (c - c0)) * 16 + lane] = h;
                        const f32x2 ag = AB[c * 16 + lane]; h = ag[0] * h + ag[1]; } }
                asm volatile("s_waitcnt lgkmcnt(0)" ::: "memory"); __builtin_amdgcn_wave_barrier();
            }
        }
        u32x4 xin[4][2];
#define RG_LOADX(c_) do { const int c__ = (c_); const int sr0 = c__ < 4 ? ML + b * CTX : b * SEQ, sl = c__ < 4 ? CTX : SEQ, t0_ = c__ < 4 ? 64 * c__ : 64 * (c__ - 4); \
        _Pragma("unroll") for (int k = 0; k < 4; ++k) { const int tl = t0_ + tt + k - 2; \
            if (tl >= 0 && tl < sl) { const bf16_t* xp = XRb + (size_t)(sr0 + tl) * 1024 + blk * 128 + cs; xin[k][0] = *(const u32x4*)xp; xin[k][1] = *(const u32x4*)(xp + 8); } \
            else { xin[k][0] = (u32x4){0u, 0u, 0u, 0u}; xin[k][1] = (u32x4){0u, 0u, 0u, 0u}; } } } while (0)
        RG_LOADX(c0);
        for (int c = c0; c < c1; ++c) {
            const int seg_row0 = c < 4 ? ML + b * CTX : b * SEQ, tl0 = c < 4 ? 64 * c : 64 * (c - 4);
            __syncthreads();
            {
                float y[16];
#pragma unroll
                for (int e = 0; e < 4; ++e) { const f32x4 bv = *(const LAS f32x4*)(CW + 512 + cs + 4 * e); y[4 * e] = bv[0]; y[4 * e + 1] = bv[1]; y[4 * e + 2] = bv[2]; y[4 * e + 3] = bv[3]; }
#pragma unroll
                for (int k = 0; k < 4; ++k)
#pragma unroll
                    for (int e = 0; e < 4; ++e) { const f32x4 wv = *(const LAS f32x4*)(CW + k * 128 + cs + 4 * e); const unsigned w0 = xin[k][e >> 1][2 * (e & 1)], w1 = xin[k][e >> 1][2 * (e & 1) + 1];
                        y[4 * e] += bflo(w0) * wv[0]; y[4 * e + 1] += bfhi(w0) * wv[1]; y[4 * e + 2] += bflo(w1) * wv[2]; y[4 * e + 3] += bfhi(w1) * wv[3]; }
                u32x4 o0, o1; o0.x = cvt_pk_bf16(y[0], y[1]); o0.y = cvt_pk_bf16(y[2], y[3]); o0.z = cvt_pk_bf16(y[4], y[5]); o0.w = cvt_pk_bf16(y[6], y[7]);
                o1.x = cvt_pk_bf16(y[8], y[9]); o1.y = cvt_pk_bf16(y[10], y[11]); o1.z = cvt_pk_bf16(y[12], y[13]); o1.w = cvt_pk_bf16(y[14], y[15]);
                *(LAS u32x4*)(XT + tt * XT_LD + cs) = o0; *(LAS u32x4*)(XT + tt * XT_LD + cs + 8) = o1;
            }
            __syncthreads();
            if (c + 1 < c1) RG_LOADX(c + 1);
            u32x4 g0, g1;
            if (PASS == 2) { const bf16_t* gp = GRb + (size_t)(seg_row0 + tl0 + lane) * 1024 + blk * 128 + cw; g0 = *(const u32x4*)gp; g1 = *(const u32x4*)(gp + 8); }
            float aggA[2] = {1.f, 1.f}, aggB[2] = {0.f, 0.f};
            float hF = PASS == 2 ? CAR[(0 * 9 + (c - c0)) * 16 + l15] : 0.f;
            float hfv[4][4], ba_[4][4], bb_[4][4], bAe[4], bBe[4], bAt[4], bBt[4];
#pragma unroll
            for (int mt = 0; mt < 4; ++mt) {
                f32x4 ag[4];
#pragma unroll
                for (int gt = 0; gt < 4; ++gt) { const float nb = (gt & 1) ? nbx[gt >> 1] : nba[gt >> 1]; ag[gt] = (f32x4){nb, nb, nb, nb}; }
#pragma unroll
                for (int ks = 0; ks < 4; ++ks) { const bf16x8 af = *(const LAS bf16x8*)(XT + (mt * 16 + l15) * XT_LD + ks * 32 + 8 * l4);
#pragma unroll
                    for (int gt = 0; gt < 4; ++gt) ag[gt] = __builtin_amdgcn_mfma_f32_16x16x32_bf16(af, Bf[gt][ks], ag[gt], 0, 0, 0); }
                float ea[2][4], eb[2][4];
#pragma unroll
                for (int r = 0; r < 4; ++r) { const int tok = mt * 16 + 4 * l4 + r;
                    const float xv = bf2f(XT[tok * XT_LD + cw + l15]);
#pragma unroll
                    for (int d = 0; d < 2; ++d) {
                        const float e1 = 1.0f + __builtin_amdgcn_exp2f(ag[2 * d][r]), e2 = 1.0f + __builtin_amdgcn_exp2f(ag[2 * d + 1][r]);
                        const float inv = __builtin_amdgcn_rcpf(e1 * e2); const float rgate = e2 * inv, igate = e1 * inv;
                        const float a = __builtin_amdgcn_exp2f(rgate * cl2[d]);
                        const float om = fmaf(-a, a, 1.0f);
                        const float bv = __builtin_amdgcn_sqrtf(om) * (igate * xv);
                        ea[d][r] = a; eb[d][r] = bv; } }
                if (PASS == 1) {
#pragma unroll
                    for (int d = 0; d < 2; ++d) {
                        float A, B;
                        if (d == 0) { A = ea[0][0]; B = eb[0][0];
#pragma unroll
                            for (int r = 1; r < 4; ++r) { B = ea[0][r] * B + eb[0][r]; A *= ea[0][r]; } }
                        else { A = ea[1][3]; B = eb[1][3];
#pragma unroll
                            for (int r = 2; r >= 0; --r) { B = ea[1][r] * B + eb[1][r]; A *= ea[1][r]; } }
                        { const float Ap = __uint_as_float(__builtin_amdgcn_ds_bpermute((lane ^ 16) << 2, __float_as_uint(A))), Bp = __uint_as_float(__builtin_amdgcn_ds_bpermute((lane ^ 16) << 2, __float_as_uint(B)));
                          const bool mefirst = d == 0 ? ((l4 & 1) == 0) : ((l4 & 1) == 1);
                          const float nB = mefirst ? Ap * B + Bp : A * Bp + B; A = A * Ap; B = nB; }
                        { const float Ap = __uint_as_float(__builtin_amdgcn_ds_bpermute((lane ^ 32) << 2, __float_as_uint(A))), Bp = __uint_as_float(__builtin_amdgcn_ds_bpermute((lane ^ 32) << 2, __float_as_uint(B)));
                          const bool mefirst = d == 0 ? (l4 < 2) : (l4 >= 2);
                          const float nB = mefirst ? Ap * B + Bp : A * Bp + B; A = A * Ap; B = nB; }
                        if (d == 0) { aggB[0] = A * aggB[0] + B; aggA[0] *= A; }
                        else { aggB[1] = aggA[1] * B + aggB[1]; aggA[1] *= A; }
                    }
                }
                if (PASS == 2) {
#define BPF(src_, v_) __uint_as_float(__builtin_amdgcn_ds_bpermute(((src_) & 63) << 2, __float_as_uint(v_)))
                    {
                        float A = ea[0][0], B = eb[0][0];
#pragma unroll
                        for (int r = 1; r < 4; ++r) { B = ea[0][r] * B + eb[0][r]; A *= ea[0][r]; }
                        { const float Ap = BPF(lane - 16, A), Bp = BPF(lane - 16, B); if (l4 >= 1) { B = A * Bp + B; A = A * Ap; } }
                        { const float Ap = BPF(lane - 32, A), Bp = BPF(lane - 32, B); if (l4 >= 2) { B = A * Bp + B; A = A * Ap; } }
                        const float At = BPF(48 + l15, A), Bt = BPF(48 + l15, B);
                        float Ae = BPF(lane - 16, A), Be = BPF(lane - 16, B); if (l4 == 0) { Ae = 1.f; Be = 0.f; }
                        float h = Ae * hF + Be;
#pragma unroll
                        for (int r = 0; r < 4; ++r) { h = ea[0][r] * h + eb[0][r]; hfv[mt][r] = h; }
                        hF = At * hF + Bt;
                    }
                    {
                        float A = ea[1][3], B = eb[1][3];
#pragma unroll
                        for (int r = 2; r >= 0; --r) { B = ea[1][r] * B + eb[1][r]; A *= ea[1][r]; }
                        { const float Ap = BPF(lane + 16, A), Bp = BPF(lane + 16, B); if (l4 <= 2) { B = A * Bp + B; A = A * Ap; } }
                        { const float Ap = BPF(lane + 32, A), Bp = BPF(lane + 32, B); if (l4 <= 1) { B = A * Bp + B; A = A * Ap; } }
                        bAt[mt] = BPF(l15, A); bBt[mt] = BPF(l15, B);
                        float Ae = BPF(lane + 16, A), Be = BPF(lane + 16, B); if (l4 == 3) { Ae = 1.f; Be = 0.f; }
                        bAe[mt] = Ae; bBe[mt] = Be;
#pragma unroll
                        for (int r = 0; r < 4; ++r) { ba_[mt][r] = ea[1][r]; bb_[mt][r] = eb[1][r]; }
                    }
                }
            }
            if (PASS == 1) { if (lane < 16) { AGG[((size_t)(b * 2 + 0) * NCH + c) * 1024 + ch] = (f32x2){aggA[0], aggB[0]}; AGG[((size_t)(b * 2 + 1) * NCH + c) * 1024 + ch] = (f32x2){aggA[1], aggB[1]}; } }
            asm volatile("s_waitcnt lgkmcnt(0)" ::: "memory"); __builtin_amdgcn_wave_barrier();
            if (PASS == 2) {
                float hB = CAR[(1 * 9 + (c - c0)) * 16 + l15];
#pragma unroll
                for (int mt = 3; mt >= 0; --mt) { float h = bAe[mt] * hB + bBe[mt];
#pragma unroll
                    for (int r = 3; r >= 0; --r) { h = ba_[mt][r] * h + bb_[mt][r]; SCF[(r + 4 * mt + 16 * l4) * 17 + l15] = hfv[mt][r] + h; }
                    hB = bAt[mt] * hB + bBt[mt]; }
                asm volatile("s_waitcnt lgkmcnt(0)" ::: "memory"); __builtin_amdgcn_wave_barrier();
                const size_t go = (size_t)(seg_row0 + tl0 + lane) * 1024 + blk * 128 + cw;
                float u[16];
                const int pl = (lane & 3) + 4 * (lane >> 4) + 16 * ((lane >> 2) & 3);
#pragma unroll
                for (int e = 0; e < 16; ++e) { const float hs = SCF[pl * 17 + e]; const unsigned gw = e < 8 ? g0[e >> 1] : g1[(e - 8) >> 1];
                    u[e] = hs * gelu_tanh((e & 1) ? bfhi(gw) : bflo(gw)); }
                u32x4 o0, o1; o0.x = cvt_pk_bf16(u[0], u[1]); o0.y = cvt_pk_bf16(u[2], u[3]); o0.z = cvt_pk_bf16(u[4], u[5]); o0.w = cvt_pk_bf16(u[6], u[7]);
                o1.x = cvt_pk_bf16(u[8], u[9]); o1.y = cvt_pk_bf16(u[10], u[11]); o1.z = cvt_pk_bf16(u[12], u[13]); o1.w = cvt_pk_bf16(u[14], u[15]);
                *(u32x4*)(GRb + go) = o0; *(u32x4*)(GRb + go + 8) = o1;
            }
            __builtin_amdgcn_wave_barrier();
        }
#undef RG_LOADX
#undef BPF
    }
}

__device__ __forceinline__ void attn_phase(const Ctx& F, int l, const bf16_t* Qb, bf16_t* Ob, const bf16_t* KVb, bool with_ctx) {
    const Params& P = *F.p;
    const int nlat = NB * 2 * 64, nun = nlat + (with_ctx ? NB * 2 * 4 : 0);
    const float* sink = P.in[18] + l * 8;
    for (int u = F.bid; u < nun; u += F.G) {
        if (u < nlat) { const int qb = u & 63, kvh = (u >> 6) & 1, b = u >> 7; att::attn_unit(F.ldsg, F.tid, Qb, Ob, KVb, b * SEQ + qb * 64, qb * 64, b, kvh, sink); }
        else { const int v = u - nlat, cb = v & 3, kvh = (v >> 2) & 1, b = v >> 3; att::attn_unit(F.ldsg, F.tid, Qb, Ob, KVb, ML + b * CTX + cb * 64, -1, b, kvh, sink); }
    }
}

__global__ void __launch_bounds__(512, 2) fwd_kernel(Params prm) {
    extern __shared__ __attribute__((aligned(16))) unsigned char shm[];
    Ctx F; F.p = &prm; F.lds = (LAS unsigned char*)shm; F.ldsg = (char*)shm;
    F.G = gridDim.x; F.bid = blockIdx.x;
    const int wave0 = __builtin_amdgcn_readfirstlane(threadIdx.x >> 6);
    if (threadIdx.x < 16) ((LAS unsigned*)(F.lds + LDS_BARST))[threadIdx.x] = 0u;
    __syncthreads();
    const XcdBarrier xbar = xcd_barrier_post((unsigned*)(prm.ws + OFF_CTL), (volatile LAS unsigned*)(F.lds + LDS_BARST));
    const int lo = prm.ph_lo, hi = prm.ph_hi;
    for (int ph = lo; ph < hi; ++ph) {
        if (ph > lo) { if (lo < 0) cg::this_grid().sync(); else xcd_barrier(xbar); }
        int wv_ = wave0; asm volatile("" : "+s"(wv_));
        int ln_; asm volatile("v_mbcnt_lo_u32_b32 %0, -1, 0\n\tv_mbcnt_hi_u32_b32 %0, -1, %0" : "=v"(ln_));
        F.wave = wv_; F.lane = ln_; F.tid = wv_ * 64 + ln_;
        size_t wz_ = 0; asm volatile("" : "+s"(wz_));
        unsigned char* ws = prm.ws + wz_;
        float* MOD = (float*)(ws + OFF_MOD);
        float* ctxres = (float*)(ws + OFF_CTX);
        bf16_t* GRb = (bf16_t*)(ws + OFF_GR); bf16_t* Qb = (bf16_t*)(ws + OFF_Q); bf16_t* KVb = (bf16_t*)(ws + OFF_KV); bf16_t* GLb = (bf16_t*)(ws + OFF_GL);
        bf16_t* RX = (bf16_t*)(ws + OFF_X); bf16_t* RY = (bf16_t*)(ws + OFF_Y);
        bf16_t* A2 = (bf16_t*)(ws + OFF_A2); bf16_t* Fb = (bf16_t*)(ws + OFF_F); bf16_t* Mx = (bf16_t*)(ws + OFF_MX);
        if (ph == 0) {
            if (F.bid == F.G - 1) { float* TAB = (float*)(ws + OFF_TAB);
                for (int i = F.tid; i < 64 * 32; i += 512) { const int pos = i >> 5, f = i & 31; float sn, cs; sincosf((float)pos * exp2f(-(float)f * (13.287712379549449f / 32.0f)), &sn, &cs); TAB[2 * i] = cs; TAB[2 * i + 1] = sn; } }
            mod_phase(F); __syncthreads(); convert_WA(F, 0); continue; }
        if (ph == 1) { norm_phase<false, true>(F, MT, prm.in[0], prm.in[2], nullptr, nullptr, nullptr, nullptr, 0, nullptr, nullptr, prm.in[6], MOD, 1024, 0, RY); continue; }
        const int l = (ph - 2) / 9, sp = (ph - 2) % 9;
        const bool lastl = (l == 1);
        bf16_t* Hl = l == 0 ? RY : RX; bf16_t* XRb = l == 0 ? RX : RY;
        bf16_t* HF = Hl; bf16_t* Gb = XRb; bf16_t* H2 = RX;
        const int Mg = lastl ? ML : MT;
        const float* xres_lat = l == 0 ? prm.in[0] : prm.out; const float* xres_ctx = l == 0 ? prm.in[2] : ctxres;
        const float* modl = MOD + (size_t)l * 5 * 6144;
        switch (sp) {
        case 0: { pg8::PlainOrder S; S.tm.init(MT, INW, F.G, F.bid); S.A = (const char*)Hl; S.B = (const char*)(ws + OFF_W + W_WIN); S.tsA = (size_t)256 * 1024 * 2; S.tsB = (size_t)256 * 1024 * 2; S.nt = 16;
                  pg8::EpiInProj E{XRb, GRb, Qb, KVb, GLb, (const float*)(ws + OFF_TAB)}; pg8::gemm_phase<false>(F.lds, F.tid, 1024, 1024, 1024, S, E); } break;
        case 1: { rglru_phase<1>(F, l, XRb, GRb); } break;
        case 2: { attn_phase(F, l, Qb, Qb, KVb, !lastl); __syncthreads(); rglru_phase<2>(F, l, XRb, GRb); } break;
        case 3: { pg8::ChainOrder S; S.tm.init(ML, 1024, F.G, F.bid); S.G = F.G; S.c = F.bid; S.nslice = lastl ? 0 : 64;
                  S.A0 = (const char*)GRb; S.B0 = (const char*)(ws + OFF_W + W_WOR); S.A1 = (const char*)Qb; S.B1 = (const char*)(ws + OFF_W + W_WOA);
                  S.tsA = (size_t)256 * 1024 * 2; S.tsB = (size_t)256 * 1024 * 2; S.nt = 16;
                  pg8::EpiMerge E{GLb, Gb, Hl};
                  pg8::gemm_phase<true>(F.lds, F.tid, 1024, 1024, 1024, S, E); } break;
        case 4: { if (!lastl) {
                      const bf16_t* SLg = Hl; bf16_t* Gc = Gb + (size_t)ML * 1024;
                      for (int i = F.bid * 512 + F.tid; i < 1024 * 1024 / 8; i += F.G * 512) { f32x4 a0 = {0.f, 0.f, 0.f, 0.f}, a1 = a0;
#pragma unroll
                          for (int sl = 0; sl < 4; ++sl) { const u32x4 w = *(const u32x4*)(SLg + (size_t)sl * (1024 * 1024) + (size_t)i * 8);
                              a0 = a0 + (f32x4){bflo(w.x), bfhi(w.x), bflo(w.y), bfhi(w.y)}; a1 = a1 + (f32x4){bflo(w.z), bfhi(w.z), bflo(w.w), bfhi(w.w)}; }
                          u32x4 o; o.x = cvt_pk_bf16(a0[0], a0[1]); o.y = cvt_pk_bf16(a0[2], a0[3]); o.z = cvt_pk_bf16(a1[0], a1[1]); o.w = cvt_pk_bf16(a1[2], a1[3]);
                          *(u32x4*)(Gc + (size_t)i * 8) = o; }
                      xcd_barrier(xbar); }
                  bf16_t* SLm = Mx + (size_t)MT * 1024;
                  pg8::EpiBf16 E{Mx, SLm};
                  pg8::SplitOrder S; S.tm.init(ML, 1024, F.G, F.bid); S.G = F.G; S.c = F.bid; S.nslice = lastl ? 0 : 64; S.A = (const char*)Gb; S.B = (const char*)(ws + OFF_W + W_WOUT); S.tsA = (size_t)256 * 1024 * 2; S.tsB = (size_t)256 * 1024 * 2; S.nt = 16;
                  S.ka = 4; S.kb = 4;
                  pg8::gemm_phase<false>(F.lds, F.tid, 1024, 1024, 1024, S, E); } break;
        case 5: { convert_WF(F, l);
                  norm_phase<true, true>(F, Mg, xres_lat, xres_ctx, Mx, lastl ? nullptr : Mx + (size_t)MT * 1024, prm.in[7] + l * 1024, modl, 2048, prm.out, ctxres, prm.in[8] + l * 1024, modl, 4096, 3072, H2); } break;
        case 6: { pg8::PlainOrder S; S.tm.init(Mg, INW, F.G, F.bid); S.A = (const char*)H2; S.B = (const char*)(ws + OFF_W + W_WFI); S.tsA = (size_t)256 * 1024 * 2; S.tsB = (size_t)256 * 1024 * 2; S.nt = 16;
                  pg8::EpiSwiGLU E{A2}; pg8::gemm_phase<false>(F.lds, F.tid, 1024, 1024, 1024, S, E); } break;
        case 7: { bf16_t* SLf = Fb + (size_t)MT * 1024;
                  pg8::EpiBf16 E{Fb, SLf};
                  pg8::SplitOrder S; S.tm.init(ML, 1024, F.G, F.bid); S.G = F.G; S.c = F.bid; S.nslice = lastl ? 0 : 64; S.A = (const char*)A2; S.B = (const char*)(ws + OFF_W + W_WFO); S.tsA = (size_t)256 * DFF * 2; S.tsB = (size_t)256 * DFF * 2; S.nt = 44;
                  S.ka = 12; S.kb = 10;
                  pg8::gemm_phase<false>(F.lds, F.tid, DFF, DFF, DFF, S, E); } break;
        case 8: { if (!lastl) { convert_WA(F, l + 1);
                      norm_phase<true, true>(F, MT, prm.out, ctxres, Fb, Fb + (size_t)MT * 1024, prm.in[9] + l * 1024, modl, 5120, prm.out, ctxres, prm.in[6] + (l + 1) * 1024, MOD + (size_t)(l + 1) * 5 * 6144, 1024, 0, RX); }
                  else norm_phase<true, false>(F, ML, prm.out, ctxres, Fb, nullptr, prm.in[9] + l * 1024, modl, 5120, prm.out, ctxres, nullptr, nullptr, 0, 0, nullptr); } break;
        }
    }
}

extern "C" void kernel_launch(void* const* d_in, const int* in_sizes, int n_in, void* d_out, int out_size, void* d_ws, size_t ws_size, hipStream_t stream) {
    static int grid = 0;
    if (grid == 0) {
        if (n_in != 24 || out_size != ML * DM || ws_size < WS_END) { fprintf(stderr, "kernel_launch: unexpected shapes (n_in %d out %d ws %zu need %zu)\n", n_in, out_size, ws_size, (size_t)WS_END); grid = -1; return; }
        int dev = 0, cus = 0, per_cu = 0;
        hipGetDevice(&dev); hipDeviceGetAttribute(&cus, hipDeviceAttributeMultiprocessorCount, dev);
        if (hipFuncSetAttribute((const void*)fwd_kernel, hipFuncAttributeMaxDynamicSharedMemorySize, LDS_BYTES) != hipSuccess) { fprintf(stderr, "kernel_launch: hipFuncSetAttribute failed\n"); grid = -1; return; }
        if (hipOccupancyMaxActiveBlocksPerMultiprocessor(&per_cu, (const void*)fwd_kernel, 512, LDS_BYTES) != hipSuccess || per_cu < 1) { fprintf(stderr, "kernel_launch: occupancy query gave %d\n", per_cu); per_cu = 1; }
        (void)hipGetLastError();
        grid = cus * (per_cu > 1 ? 1 : per_cu);
        fprintf(stderr, "kernel_launch: grid %d (cus %d per_cu %d)\n", grid, cus, per_cu);
    }
    if (grid < 0) return;
    Params p{};
    for (int i = 0; i < 24; ++i) p.in[i] = (const float*)d_in[i];
    p.out = (float*)d_out; p.ws = (unsigned char*)d_ws;
    if (hipMemsetAsync((char*)d_ws + OFF_CTL, 0, CTL_BYTES, stream) != hipSuccess) { fprintf(stderr, "kernel_launch: memset failed\n"); return; }
#if MK_PER_PHASE
    for (int ph = 0; ph < NPHASE; ++ph) { p.ph_lo = ph; p.ph_hi = ph + 1; hipLaunchKernelGGL(fwd_kernel, dim3(grid), dim3(512), LDS_BYTES, stream, p); }
#else
    p.ph_lo = 0; p.ph_hi = NPHASE;
    void* args[] = {&p};
    hipError_t e = hipLaunchCooperativeKernel((const void*)fwd_kernel, dim3(grid), dim3(512), args, LDS_BYTES, stream);
    if (e != hipSuccess) fprintf(stderr, "kernel_launch: cooperative launch failed: %s (grid %d)\n", hipGetErrorString(e), grid);
#endif
}
```

```cpp
#include <hip/hip_runtime.h>
#include <hip/hip_cooperative_groups.h>
#include <cstdio>
#include <cstdint>
namespace cg = cooperative_groups;

#ifndef MK_PER_PHASE
#define MK_PER_PHASE 0
#endif

#define LAS __attribute__((address_space(3)))
typedef unsigned short bf16_t;
typedef short bf16x8 __attribute__((ext_vector_type(8)));
typedef short s16x4 __attribute__((ext_vector_type(4)));
typedef float f32x4 __attribute__((ext_vector_type(4)));
typedef float f32x2 __attribute__((ext_vector_type(2)));
typedef float f32x16 __attribute__((ext_vector_type(16)));
typedef unsigned u32x4 __attribute__((ext_vector_type(4)));
typedef unsigned u32x2 __attribute__((ext_vector_type(2)));

constexpr int DM = 1024, NB = 4, SEQ = 4096, CTX = 256;
constexpr int ML = NB * SEQ, MC = NB * CTX, MT = ML + MC;
constexpr int INW = 5632, DFF = 2816, NCH = 68;
constexpr float EPS = 1e-6f;
constexpr int NPHASE = 20;

constexpr size_t MB1 = (size_t)MT * 1024 * 2;
constexpr size_t OFF_W = 0;
constexpr size_t W_WIN = 0, W_WG = 11534336, W_WOR = W_WG + 1048576, W_WOA = W_WOR + 2097152, W_WOUT = W_WOA + 2097152;
constexpr size_t W_WFI = 0, W_WFO = 11534336;
constexpr size_t OFF_CTX = 18874368;
constexpr size_t OFF_MOD = OFF_CTX + 4194304;
constexpr size_t OFF_AGG = OFF_MOD + 245760;
constexpr size_t OFF_X = OFF_AGG + 4456448;
constexpr size_t OFF_GR = OFF_X + MB1;
constexpr size_t OFF_Q = OFF_GR + MB1;
constexpr size_t OFF_KV = OFF_Q + MB1;
constexpr size_t OFF_GL = OFF_KV + (size_t)MT * 512 * 2;
constexpr size_t OFF_Y = OFF_GL + (size_t)MT * 2048 * 2;
constexpr size_t OFF_CTL = OFF_Y + MB1, CTL_BYTES = 16384;
constexpr size_t OFF_TAB = OFF_CTL + CTL_BYTES, TAB_BYTES = 64 * 32 * 8;
constexpr size_t WS_END = OFF_TAB + TAB_BYTES;
constexpr size_t OFF_A2 = OFF_GR;
constexpr size_t OFF_F = OFF_CTL - (size_t)MT * 1024 * 4;
constexpr size_t OFF_MX = OFF_GL;
static_assert(OFF_A2 + (size_t)MT * DFF * 2 <= OFF_F, "A2/F overlap");
static_assert(WS_END <= 268435456, "workspace");

constexpr int LDS_BYTES = 163840;
constexpr int LDS_BARST = LDS_BYTES - 64;

__device__ __forceinline__ unsigned cvt_pk_bf16(float lo, float hi) { unsigned r; asm volatile("v_cvt_pk_bf16_f32 %0, %1, %2" : "=v"(r) : "v"(lo), "v"(hi)); return r; }
__device__ __forceinline__ float bf2f(unsigned short v) { return __uint_as_float(((unsigned)v) << 16); }
__device__ __forceinline__ float bflo(unsigned w) { return __uint_as_float(w << 16); }
__device__ __forceinline__ float bfhi(unsigned w) { return __uint_as_float(w & 0xffff0000u); }
__device__ __forceinline__ float sigmoidf_(float x) { return __builtin_amdgcn_rcpf(1.0f + __expf(-x)); }
__device__ __forceinline__ float siluf_(float x) { return x * __builtin_amdgcn_rcpf(1.0f + __expf(-x)); }
__device__ __forceinline__ float gelu_tanh(float x) { const float u = 0.7978845608028654f * (x + 0.044715f * x * x * x); const float t = 1.0f - 2.0f * __builtin_amdgcn_rcpf(1.0f + __expf(2.0f * u)); return 0.5f * x * (1.0f + t); }
__device__ __forceinline__ float wave_sum(float v, int lane) {
#pragma unroll
    for (int o = 1; o < 64; o <<= 1) v += __uint_as_float(__builtin_amdgcn_ds_bpermute((lane ^ o) << 2, __float_as_uint(v)));
    return v;
}

namespace pg8 {
constexpr int BM = 256, BK = 64, HALF = 128, HTB = HALF * BK * 2, STAGE_BYTES = 8 * HTB, NXCD = 8, WGM = 8;
__device__ __forceinline__ int lds_byte(int r, int c) { const int st = (r >> 4) * 2 + (c >> 5), rr = r & 15, cc = c & 31, ob = rr * 64 + cc * 2; return st * 1024 + (ob ^ (((ob >> 9) & 1) << 5)); }
__device__ __forceinline__ void stage_rc(int b, int& R, int& C) { const int st = b / 1024, sb = b % 1024, swz = sb ^ (((sb >> 9) & 1) << 5); R = (st >> 1) * 16 + swz / 64; C = (st & 1) * 32 + (swz % 64) / 2; }
__device__ __forceinline__ int perm32(int rho) { const int n = rho >> 4, i = rho & 15; return 8 * (i >> 2) + 4 * n + (i & 3); }

struct Unit { int pm, pn; const char* A; const char* B; int chain; int nt; int slab; };

struct TileMap {
    int nM, nN, nwg, G, c;
    __device__ void init(int M, int N, int G_, int c_) { nM = M / BM; nN = N / BM; nwg = nM * nN; G = G_; c = c_; }
    __device__ bool tile(int i, int& pm, int& pn) const {
        const long L = (long)i * G + c; if (L >= nwg) return false;
        int wgid = (int)L; { const int q = nwg / NXCD, r = nwg % NXCD, xcd = wgid % NXCD, off = wgid / NXCD; wgid = (xcd < r ? xcd * (q + 1) : r * (q + 1) + (xcd - r) * q) + off; }
        const int nig = WGM * nN, gid = wgid / nig, fm = gid * WGM, gsz = (nM - fm) < WGM ? (nM - fm) : WGM;
        pm = fm + ((wgid % nig) % gsz); pn = (wgid % nig) / gsz; return true;
    }
};
struct PlainOrder {
    TileMap tm; const char* A; const char* B; size_t tsA, tsB; int nt;
    __device__ bool next(int i, Unit& u) const { if (!tm.tile(i, u.pm, u.pn)) return false; u.A = A + (size_t)u.pm * tsA; u.B = B + (size_t)u.pn * tsB; u.chain = 0; u.nt = nt; u.slab = -1; return true; }
};
struct SplitOrder {
    TileMap tm; const char* A; const char* B; size_t tsA, tsB; int nt; int G, c; int nslice; int ka, kb;
    __device__ bool next(int i, Unit& u) const {
        const long L = (long)i * G + c;
        if (L < 256) { if (!tm.tile(i, u.pm, u.pn)) return false; u.A = A + (size_t)u.pm * tsA; u.B = B + (size_t)u.pn * tsB; u.chain = 0; u.nt = nt; u.slab = -1; return true; }
        const int j = (int)(L - 256); if (j >= nslice) return false;
        const int t = j >> 2, sl = j & 3; u.pm = 64 + (t >> 2); u.pn = t & 3; u.chain = 0; u.slab = sl;
        const int kk = sl < 2 ? ka * sl : 2 * ka + kb * (sl - 2); u.nt = sl < 2 ? ka : kb;
        u.A = A + (size_t)u.pm * tsA + (size_t)kk * 128; u.B = B + (size_t)u.pn * tsB + (size_t)kk * 128; return true;
    }
};
struct ChainOrder {
    TileMap tm; const char* A0; const char* B0; const char* A1; const char* B1; size_t tsA, tsB; int nt; int G, c, nslice;
    __device__ bool next(int i, Unit& u) const { const int part = i & 1; u.chain = part ? 0 : 1;
        if (nslice == 0) { if (!tm.tile(i >> 1, u.pm, u.pn)) return false; u.nt = nt; u.slab = -1;
            u.A = (part ? A1 : A0) + (size_t)u.pm * tsA; u.B = (part ? B1 : B0) + (size_t)u.pn * tsB; return true; }
        const long L = (long)(i >> 1) * G + c;
        if (L < 256) { if (!tm.tile(i >> 1, u.pm, u.pn)) return false; u.nt = nt; u.slab = -1;
            u.A = (part ? A1 : A0) + (size_t)u.pm * tsA; u.B = (part ? B1 : B0) + (size_t)u.pn * tsB; return true; }
        const int j = (int)(L - 256); if (j >= nslice) return false;
        const int t = j >> 2, sl = j & 3; u.pm = 64 + (t >> 2); u.pn = t & 3; u.slab = sl; u.nt = 4;
        u.A = (part ? A1 : A0) + (size_t)u.pm * tsA + (size_t)sl * 512; u.B = (part ? B1 : B0) + (size_t)u.pn * tsB + (size_t)sl * 512; return true; }
};

template <bool CHAIN, class Epi, class Sched>
__device__ __forceinline__ void gemm_phase(LAS unsigned char* lds, const int tid, const int K, const int lda, const int ldb, const Sched& S, const Epi& E) {
    const int wid = __builtin_amdgcn_readfirstlane(tid >> 6), lane = tid & 63, wr = wid >> 2, wc = wid & 3, fr = lane & 15, fq = lane >> 4;
    unsigned voffA[2], voffB[2];
#pragma unroll
    for (int i = 0; i < 2; ++i) { int R, C; stage_rc(tid * 16 + i * 8192, R, C); const int Rb = Epi::PERM ? ((R & ~31) + perm32(R & 31)) : R;
        voffA[i] = (unsigned)(R * lda + C) * 2u; voffB[i] = (unsigned)(Rb * ldb + C) * 2u; }
    const size_t kstep = (size_t)(BK * 2);
    const size_t hstepA = (size_t)HALF * lda * 2, hstepB = (size_t)HALF * ldb * 2;
    const unsigned ldsw = (unsigned)wid * 1024u;
    const int aoff = lds_byte(wr * 64 + fr, fq * 8), boff = lds_byte(wc * 32 + fr, fq * 8);
#define PG8_SA(b, h) (((b) * 2 + (h)) * HTB)
#define PG8_SB(b, h) ((4 + (b) * 2 + (h)) * HTB)
#define PG8_STAGE(bufoff, gbase, voff) do { _Pragma("unroll") for (int _i = 0; _i < 2; ++_i) \
        __builtin_amdgcn_global_load_lds((const unsigned*)((const char*)(gbase) + (voff)[_i]), (LAS unsigned*)(lds + (bufoff) + ldsw + _i * 8192), 16, 0, 0); } while (0)
#define PG8_LDA(dst, b, h) do { _Pragma("unroll") for (int m = 0; m < 4; ++m) _Pragma("unroll") for (int k = 0; k < 2; ++k) dst[m][k] = *(const LAS bf16x8*)(lds + PG8_SA(b, h) + aoff + m * 2048 + k * 1024); } while (0)
#define PG8_LDB(dst, b, h) do { _Pragma("unroll") for (int n = 0; n < 2; ++n) _Pragma("unroll") for (int k = 0; k < 2; ++k) dst[n][k] = *(const LAS bf16x8*)(lds + PG8_SB(b, h) + boff + n * 2048 + k * 1024); } while (0)
#define PG8_MMA(ai, bj, At, Bt) do { __builtin_amdgcn_s_setprio(1); _Pragma("unroll") for (int m = 0; m < 4; ++m) _Pragma("unroll") for (int n = 0; n < 2; ++n) _Pragma("unroll") for (int k = 0; k < 2; ++k) \
        acc[ai][bj][m][n] = __builtin_amdgcn_mfma_f32_16x16x32_bf16(Bt[n][k], At[m][k], acc[ai][bj][m][n], 0, 0, 0); __builtin_amdgcn_s_setprio(0); } while (0)
#define PG8_WAIT_V(n) asm volatile("s_waitcnt vmcnt(" #n ")" ::: "memory")
#define PG8_WAIT_L(n) asm volatile("s_waitcnt lgkmcnt(" #n ")" ::: "memory")
#define PG8_BAR __builtin_amdgcn_s_barrier()
#define PG8_SCHED __builtin_amdgcn_sched_barrier(0)
#define PG8_KLOOP(cA_, cB_, nA_, nB_, nt_) do { const int nt__ = (nt_); \
        for (int t = 0; t < nt__; t += 2) { \
            const bool last = (t == nt__ - 2); \
            const char* a1 = (cA_) + (size_t)(t + 1) * kstep; \
            const char* a2 = last ? (nA_) : (cA_) + (size_t)(t + 2) * kstep; const char* b2 = last ? (nB_) : (cB_) + (size_t)(t + 2) * kstep; \
            const char* a3 = a2 + kstep; const char* b3 = b2 + kstep; \
            PG8_LDB(B0, 0, 0); PG8_LDB(B1, 0, 1); PG8_SCHED; PG8_LDA(At, 0, 0); PG8_STAGE(PG8_SA(1, 1), a1 + hstepA, voffA); \
            PG8_WAIT_V(8); PG8_WAIT_L(0); PG8_BAR; PG8_MMA(0, 0, At, B0); PG8_MMA(0, 1, At, B1); PG8_BAR; PG8_SCHED; \
            PG8_LDA(At, 0, 1); PG8_STAGE(PG8_SB(0, 0), b2, voffB); PG8_STAGE(PG8_SB(0, 1), b2 + hstepB, voffB); PG8_STAGE(PG8_SA(0, 0), a2, voffA); \
            PG8_WAIT_V(8); PG8_WAIT_L(0); PG8_BAR; PG8_MMA(1, 0, At, B0); PG8_MMA(1, 1, At, B1); PG8_BAR; PG8_SCHED; \
            PG8_LDB(B0, 1, 0); PG8_LDB(B1, 1, 1); PG8_SCHED; PG8_LDA(At, 1, 0); PG8_STAGE(PG8_SA(0, 1), a2 + hstepA, voffA); \
            PG8_WAIT_V(8); PG8_WAIT_L(0); PG8_BAR; PG8_MMA(0, 0, At, B0); PG8_MMA(0, 1, At, B1); PG8_BAR; PG8_SCHED; \
            PG8_LDA(At, 1, 1); PG8_STAGE(PG8_SB(1, 0), b3, voffB); PG8_STAGE(PG8_SB(1, 1), b3 + hstepB, voffB); PG8_STAGE(PG8_SA(1, 0), a3, voffA); \
            PG8_WAIT_V(8); PG8_WAIT_L(0); PG8_BAR; PG8_MMA(1, 0, At, B0); PG8_MMA(1, 1, At, B1); PG8_BAR; PG8_SCHED; \
        } } while (0)
#define PG8_EPI_IDS int l2_ = lane; asm volatile("" : "+v"(l2_)); const int fr2 = l2_ & 15, fq2 = l2_ >> 4
    Unit cur, nxt; int ui = 0;
    if (!S.next(0, cur)) return;
    f32x4 acc[2][2][4][2];
#pragma unroll
    for (int a = 0; a < 2; ++a)
#pragma unroll
        for (int b = 0; b < 2; ++b)
#pragma unroll
            for (int m = 0; m < 4; ++m)
#pragma unroll
                for (int n = 0; n < 2; ++n) acc[a][b][m][n] = (f32x4){0.f, 0.f, 0.f, 0.f};
    bf16x8 At[4][2], B0[2][2], B1[2][2];
    {
        const char* cA = cur.A; const char* cB = cur.B;
        PG8_STAGE(PG8_SB(0, 0), cB, voffB); PG8_STAGE(PG8_SB(0, 1), cB + hstepB, voffB); PG8_STAGE(PG8_SA(0, 0), cA, voffA); PG8_STAGE(PG8_SA(0, 1), cA + hstepA, voffA);
        if (wr == 1) PG8_BAR;
        PG8_WAIT_V(2); PG8_BAR;
        PG8_STAGE(PG8_SB(1, 0), cB + kstep, voffB); PG8_STAGE(PG8_SA(1, 0), cA + kstep, voffA); PG8_STAGE(PG8_SB(1, 1), cB + hstepB + kstep, voffB);
        PG8_WAIT_V(6); PG8_BAR;
    }
    for (;;) {
        bool has_next;
        if constexpr (CHAIN) {
            Unit c2; (void)S.next(ui + 1, c2);
            PG8_KLOOP(cur.A, cur.B, c2.A, c2.B, cur.nt);
            if (wr == 0) PG8_BAR;
            { PG8_EPI_IDS; E.mid(acc, cur, wr, wc, fr2, fq2); }
            if (wr == 1) PG8_BAR;
            ++ui;
            has_next = S.next(ui + 1, nxt);
            const char* nA = has_next ? nxt.A : c2.A; const char* nB = has_next ? nxt.B : c2.B;
            PG8_KLOOP(c2.A, c2.B, nA, nB, c2.nt);
            if (wr == 0) PG8_BAR;
            { PG8_EPI_IDS; E(acc, c2, wr, wc, fr2, fq2); }
        } else {
            has_next = S.next(ui + 1, nxt);
            const char* nA = has_next ? nxt.A : cur.A; const char* nB = has_next ? nxt.B : cur.B;
            PG8_KLOOP(cur.A, cur.B, nA, nB, cur.nt);
            if (wr == 0) PG8_BAR;
            { PG8_EPI_IDS; E(acc, cur, wr, wc, fr2, fq2); }
        }
        if (!has_next) break;
#pragma unroll
        for (int a = 0; a < 2; ++a)
#pragma unroll
            for (int b = 0; b < 2; ++b)
#pragma unroll
                for (int m = 0; m < 4; ++m)
#pragma unroll
                    for (int n = 0; n < 2; ++n) acc[a][b][m][n] = (f32x4){0.f, 0.f, 0.f, 0.f};
        cur = nxt; ++ui;
        if (wr == 1) PG8_BAR;
    }
    PG8_WAIT_V(0);
    PG8_BAR;
#undef PG8_SA
#undef PG8_SB
#undef PG8_STAGE
#undef PG8_LDA
#undef PG8_LDB
#undef PG8_MMA
#undef PG8_WAIT_V
#undef PG8_WAIT_L
#undef PG8_BAR
#undef PG8_SCHED
#undef PG8_KLOOP
#undef PG8_EPI_IDS
}

struct EpiInProj {
    static constexpr bool PERM = true;
    bf16_t *XR, *GR, *Q, *KV, *GL; const float* TAB;
    __device__ __forceinline__ void mid(f32x4 (&acc)[2][2][4][2], const Unit& u, int wr, int wc, int fr, int fq) const {}
    template <int LDC> __device__ __forceinline__ void store(const f32x4 (&acc)[2][2][4][2], bf16_t* base, int row0) const {
        bf16_t* rp = base + (size_t)row0 * LDC;
#pragma unroll
        for (int ai = 0; ai < 2; ++ai)
#pragma unroll
            for (int m = 0; m < 4; ++m) { bf16_t* rowp = rp + (size_t)(ai * HALF + m * 16) * LDC;
#pragma unroll
                for (int bj = 0; bj < 2; ++bj) { const f32x4 v0 = acc[ai][bj][m][0], v1 = acc[ai][bj][m][1];
                    u32x4 w; w.x = cvt_pk_bf16(v0[0], v0[1]); w.y = cvt_pk_bf16(v0[2], v0[3]); w.z = cvt_pk_bf16(v1[0], v1[1]); w.w = cvt_pk_bf16(v1[2], v1[3]);
                    *(u32x4*)(rowp + bj * HALF) = w; } }
    }
    template <int LDC> __device__ __forceinline__ void store_rope(const f32x4 (&acc)[2][2][4][2], bf16_t* base, int row0, int wc, int fq) const {
        bf16_t* rp = base + (size_t)row0 * LDC; const int axis = wc >> 1, f0 = 16 * (wc & 1) + 4 * fq;
#pragma unroll
        for (int ai = 0; ai < 2; ++ai)
#pragma unroll
            for (int m = 0; m < 4; ++m) { const int row = row0 + ai * HALF + m * 16; bf16_t* rowp = rp + (size_t)(ai * HALF + m * 16) * LDC;
                const int t = row & (SEQ - 1), pos = axis ? (t & 63) : (t >> 6);
                f32x4 cs0 = *(const f32x4*)(TAB + (pos * 32 + f0) * 2), cs1 = *(const f32x4*)(TAB + (pos * 32 + f0) * 2 + 4);
                if (row >= ML) { cs0 = (f32x4){1.f, 0.f, 1.f, 0.f}; cs1 = cs0; }
#pragma unroll
                for (int bj = 0; bj < 2; ++bj) { const f32x4 x1 = acc[ai][bj][m][0], x2 = acc[ai][bj][m][1];
                    u32x4 w;
                    w.x = cvt_pk_bf16(x1[0] * cs0[0] - x2[0] * cs0[1], x1[1] * cs0[2] - x2[1] * cs0[3]);
                    w.y = cvt_pk_bf16(x1[2] * cs1[0] - x2[2] * cs1[1], x1[3] * cs1[2] - x2[3] * cs1[3]);
                    w.z = cvt_pk_bf16(x2[0] * cs0[0] + x1[0] * cs0[1], x2[1] * cs0[2] + x1[1] * cs0[3]);
                    w.w = cvt_pk_bf16(x2[2] * cs1[0] + x1[2] * cs1[1], x2[3] * cs1[2] + x1[3] * cs1[3]);
                    *(u32x4*)(rowp + bj * HALF) = w; } }
    }
    __device__ __forceinline__ void operator()(const f32x4 (&acc)[2][2][4][2], const Unit& u, int wr, int wc, int fr, int fq) const {
        const int pn = u.pn; const int row0 = u.pm * BM + wr * 64 + fr, col0 = wc * 32 + 8 * fq;
        if (pn < 8) { bf16_t* base = (pn < 4 ? XR + pn * 256 : GR + (pn - 4) * 256) + col0; store<1024>(acc, base, row0); }
        else if (pn < 12) { store_rope<1024>(acc, Q + (pn - 8) * 256 + col0, row0, wc, fq); }
        else if (pn == 12) { store_rope<512>(acc, KV + col0, row0, wc, fq); }
        else if (pn == 13) { store<512>(acc, KV + 256 + col0, row0); }
        else { store<2048>(acc, GL + (pn - 14) * 256 + col0, row0); }
    }
};
struct EpiSwiGLU {
    static constexpr bool PERM = true;
    bf16_t* O;
    __device__ __forceinline__ void mid(f32x4 (&acc)[2][2][4][2], const Unit& u, int wr, int wc, int fr, int fq) const {}
    __device__ __forceinline__ void operator()(const f32x4 (&acc)[2][2][4][2], const Unit& u, int wr, int wc, int fr, int fq) const {
        const int row0 = u.pm * BM + wr * 64 + fr, col0 = u.pn * 128 + wc * 32 + 8 * fq;
#pragma unroll
        for (int ai = 0; ai < 2; ++ai)
#pragma unroll
            for (int m = 0; m < 4; ++m) { bf16_t* rowp = O + (size_t)(row0 + ai * HALF + m * 16) * DFF + col0;
                float r[8];
#pragma unroll
                for (int n = 0; n < 2; ++n)
#pragma unroll
                    for (int j = 0; j < 4; ++j) r[n * 4 + j] = siluf_(acc[ai][0][m][n][j]) * acc[ai][1][m][n][j];
                u32x4 w; w.x = cvt_pk_bf16(r[0], r[1]); w.y = cvt_pk_bf16(r[2], r[3]); w.z = cvt_pk_bf16(r[4], r[5]); w.w = cvt_pk_bf16(r[6], r[7]);
                *(u32x4*)rowp = w; }
    }
};
struct EpiMerge {
    static constexpr bool PERM = true;
    const bf16_t* GL; bf16_t* G; bf16_t* SL;
    __device__ __forceinline__ void mid(f32x4 (&acc)[2][2][4][2], const Unit& u, int wr, int wc, int fr, int fq) const {
        const int row0 = u.pm * BM + wr * 64 + fr, col0 = u.pn * BM + wc * 32 + 8 * fq;
#pragma unroll
        for (int ai = 0; ai < 2; ++ai)
#pragma unroll
            for (int m = 0; m < 4; ++m) { const bf16_t* gp = GL + (size_t)(row0 + ai * HALF + m * 16) * 2048 + col0;
#pragma unroll
                for (int bj = 0; bj < 2; ++bj) { const u32x4 la = *(const u32x4*)(gp + bj * HALF), lb = *(const u32x4*)(gp + 1024 + bj * HALF);
#pragma unroll
                    for (int n = 0; n < 2; ++n)
#pragma unroll
                        for (int j = 0; j < 4; ++j) { const int e = n * 4 + j; const unsigned wa = la[e >> 1], wb = lb[e >> 1];
                            const float a = (e & 1) ? bfhi(wa) : bflo(wa), b = (e & 1) ? bfhi(wb) : bflo(wb);
                            acc[ai][bj][m][n][j] *= (1.0f + __expf(-b)) * __builtin_amdgcn_rcpf(1.0f + __expf(-a)); }
                    asm volatile("" : "+v"(acc[ai][bj][m][0]), "+v"(acc[ai][bj][m][1]) :: "memory"); } }
    }
    __device__ __forceinline__ void operator()(const f32x4 (&acc)[2][2][4][2], const Unit& u, int wr, int wc, int fr, int fq) const {
        const int row0 = u.pm * BM + wr * 64 + fr, col0 = u.pn * BM + wc * 32 + 8 * fq;
        bf16_t* gout = u.slab < 0 ? G : SL + (size_t)u.slab * (1024 * 1024) - (size_t)ML * 1024;
#pragma unroll
        for (int ai = 0; ai < 2; ++ai)
#pragma unroll
            for (int m = 0; m < 4; ++m) { const size_t r = (size_t)(row0 + ai * HALF + m * 16);
#pragma unroll
                for (int bj = 0; bj < 2; ++bj) { const u32x4 lb = *(const u32x4*)(GL + r * 2048 + 1024 + col0 + bj * HALF); float o[8];
#pragma unroll
                    for (int n = 0; n < 2; ++n)
#pragma unroll
                        for (int j = 0; j < 4; ++j) { const int e = n * 4 + j; const unsigned wb = lb[e >> 1]; const float b = (e & 1) ? bfhi(wb) : bflo(wb);
                            o[e] = acc[ai][bj][m][n][j] * __builtin_amdgcn_rcpf(1.0f + __expf(-b)); }
                    u32x4 w; w.x = cvt_pk_bf16(o[0], o[1]); w.y = cvt_pk_bf16(o[2], o[3]); w.z = cvt_pk_bf16(o[4], o[5]); w.w = cvt_pk_bf16(o[6], o[7]);
                    *(u32x4*)(gout + r * 1024 + col0 + bj * HALF) = w; asm volatile("" ::: "memory"); } }
    }
};
struct EpiBf16 {
    static constexpr bool PERM = true;
    bf16_t* O; bf16_t* SL;
    __device__ __forceinline__ void mid(f32x4 (&acc)[2][2][4][2], const Unit& u, int wr, int wc, int fr, int fq) const {}
    __device__ __forceinline__ void operator()(const f32x4 (&acc)[2][2][4][2], const Unit& u, int wr, int wc, int fr, int fq) const {
        const int row0 = u.pm * BM + wr * 64 + fr, col0 = u.pn * BM + wc * 32 + 8 * fq;
        bf16_t* ob = u.slab < 0 ? O : SL + (size_t)u.slab * (1024 * 1024) - (size_t)ML * 1024;
#pragma unroll
        for (int ai = 0; ai < 2; ++ai)
#pragma unroll
            for (int m = 0; m < 4; ++m) { bf16_t* rowp = ob + (size_t)(row0 + ai * HALF + m * 16) * 1024 + col0;
#pragma unroll
                for (int bj = 0; bj < 2; ++bj) { const f32x4 v0 = acc[ai][bj][m][0], v1 = acc[ai][bj][m][1];
                    u32x4 w; w.x = cvt_pk_bf16(v0[0], v0[1]); w.y = cvt_pk_bf16(v0[2], v0[3]); w.z = cvt_pk_bf16(v1[0], v1[1]); w.w = cvt_pk_bf16(v1[2], v1[3]);
                    *(u32x4*)(rowp + bj * HALF) = w; } }
    }
};
struct EpiF32 {
    static constexpr bool PERM = false;
    float* O;
    __device__ __forceinline__ void mid(f32x4 (&acc)[2][2][4][2], const Unit& u, int wr, int wc, int fr, int fq) const {}
    __device__ __forceinline__ void operator()(const f32x4 (&acc)[2][2][4][2], const Unit& u, int wr, int wc, int fr, int fq) const {
        const int row0 = u.pm * BM + wr * 64 + fr, col0 = u.pn * BM + wc * 32 + 4 * fq;
#pragma unroll
        for (int ai = 0; ai < 2; ++ai)
#pragma unroll
            for (int m = 0; m < 4; ++m) { float* rowp = O + (size_t)(row0 + ai * HALF + m * 16) * 1024 + col0;
#pragma unroll
                for (int bj = 0; bj < 2; ++bj)
#pragma unroll
                    for (int n = 0; n < 2; ++n) *(f32x4*)(rowp + bj * HALF + n * 16) = acc[ai][bj][m][n]; }
    }
};
}

namespace att {
constexpr float SCALE = 0.088388347648318440f;
constexpr float THR = 8.f;
constexpr int SHM_V = 64 * 128 * 2, SHM_K = 64 * 128 * 2;
#define KSWZ(row, colB) ((row) * 256 + ((colB) ^ (((row) & 7) << 4)))
#define SBAR() __builtin_amdgcn_sched_barrier(0)
__device__ __forceinline__ int crow(int r, int hi) { return (r & 3) + 8 * (r >> 2) + 4 * hi; }
__device__ __forceinline__ void partialSM(f32x16& p0, f32x16& p1, float& m_reg, float& mn, float& alpha) {
    constexpr float C = SCALE * 1.4426950408889634f;
    float pmax = p0[0];
#pragma unroll
    for (int r = 1; r < 16; ++r) pmax = fmaxf(pmax, p0[r]);
#pragma unroll
    for (int r = 0; r < 16; ++r) pmax = fmaxf(pmax, p1[r]);
    { auto rr = __builtin_amdgcn_permlane32_swap(__float_as_uint(pmax), __float_as_uint(pmax), false, false);
      pmax = fmaxf(__uint_as_float(rr[0]), __uint_as_float(rr[1])); }
    if (__builtin_expect(__all(pmax - m_reg <= THR / SCALE), 1)) { mn = m_reg; alpha = 1.f; }
    else { mn = fmaxf(m_reg, pmax); alpha = __builtin_amdgcn_exp2f((m_reg - mn) * C); m_reg = mn; }
    const float mnC = -mn * C;
#pragma unroll
    for (int r = 0; r < 16; ++r) p0[r] = fmaf(p0[r], C, mnC);
#pragma unroll
    for (int r = 0; r < 16; ++r) p1[r] = fmaf(p1[r], C, mnC);
#pragma unroll
    for (int r = 0; r < 16; ++r) p0[r] = __builtin_amdgcn_exp2f(p0[r]);
}
__device__ __forceinline__ void finishSM(f32x16& p0, f32x16& p1, float alpha, float& l_reg, bf16x8& pa0, bf16x8& pa1, bf16x8& pa2, bf16x8& pa3) {
#pragma unroll
    for (int r = 0; r < 16; ++r) p1[r] = __builtin_amdgcn_exp2f(p1[r]);
    float ps = 0;
#pragma unroll
    for (int r = 0; r < 16; ++r) ps += p0[r];
#pragma unroll
    for (int r = 0; r < 16; ++r) ps += p1[r];
    { auto rr = __builtin_amdgcn_permlane32_swap(__float_as_uint(ps), __float_as_uint(ps), false, false);
      ps = __uint_as_float(rr[0]) + __uint_as_float(rr[1]); }
    l_reg = l_reg * alpha + ps;
#define PK4(P, BASE, OUT) do { unsigned a0 = cvt_pk_bf16(P[BASE + 0], P[BASE + 1]), a1 = cvt_pk_bf16(P[BASE + 2], P[BASE + 3]);   \
    unsigned b0 = cvt_pk_bf16(P[BASE + 4], P[BASE + 5]), b1 = cvt_pk_bf16(P[BASE + 6], P[BASE + 7]);                              \
    auto r0 = __builtin_amdgcn_permlane32_swap(a0, b0, false, false); auto r1 = __builtin_amdgcn_permlane32_swap(a1, b1, false, false); \
    u32x4 w = {r0[0], r1[0], r0[1], r1[1]}; OUT = *reinterpret_cast<bf16x8*>(&w); } while (0)
    PK4(p0, 0, pa0); PK4(p0, 8, pa1); PK4(p1, 0, pa2); PK4(p1, 8, pa3);
#undef PK4
}
__device__ __forceinline__ void qkt(f32x16& p0, f32x16& p1, const char* Ks, const bf16x8* qr, int r32, int hi) {
    p0 = f32x16{}; p1 = f32x16{};
#pragma unroll
    for (int d0 = 0; d0 < 8; ++d0) { const int cb = (d0 * 16 + hi * 8) * 2;
        const bf16x8 b0 = *reinterpret_cast<const bf16x8*>(Ks + KSWZ(r32, cb));
        const bf16x8 b1 = *reinterpret_cast<const bf16x8*>(Ks + KSWZ(32 + r32, cb));
        p0 = __builtin_amdgcn_mfma_f32_32x32x16_bf16(b0, qr[d0], p0, 0, 0, 0);
        p1 = __builtin_amdgcn_mfma_f32_32x32x16_bf16(b1, qr[d0], p1, 0, 0, 0); }
}
__device__ __forceinline__ int v_st(int k, int c) { const int kk = (k & ~0xC) | ((k & 4) << 1) | ((k & 8) >> 1); return ((kk >> 3) * 4 + (c >> 5)) * 512 + ((kk & 7) * 32 + (c & 31)) * 2; }
__device__ __forceinline__ int v_rd_base(int lane) { return ((lane & 3) << 3) | (((lane >> 2) & 3) << 6) | (((lane >> 4) & 1) << 5) | (((lane >> 5) & 1) << 8); }
constexpr int v_rd_off(int d0, int ks, int half) { return d0 * 512 + ks * 4096 + half * 2048; }
template <int OFF> __device__ __forceinline__ s16x4 tr_read(int vb) {
    s16x4 r; asm volatile("ds_read_b64_tr_b16 %0, %1 offset:%2" : "=&v"(r) : "v"(vb), "i"(OFF) : "memory"); return r;
}
template <int D0> __device__ __forceinline__ void pv_one(f32x16& od, int vb, bf16x8 pa0, bf16x8 pa1, bf16x8 pa2, bf16x8 pa3) {
    const s16x4 l0 = tr_read<v_rd_off(D0, 0, 0)>(vb), h0 = tr_read<v_rd_off(D0, 0, 1)>(vb), l1 = tr_read<v_rd_off(D0, 1, 0)>(vb), h1 = tr_read<v_rd_off(D0, 1, 1)>(vb);
    const s16x4 l2 = tr_read<v_rd_off(D0, 2, 0)>(vb), h2 = tr_read<v_rd_off(D0, 2, 1)>(vb), l3 = tr_read<v_rd_off(D0, 3, 0)>(vb), h3 = tr_read<v_rd_off(D0, 3, 1)>(vb);
    asm volatile("s_waitcnt lgkmcnt(0)" ::: "memory"); SBAR();
#define PK(L, H) (bf16x8){L[0], L[1], L[2], L[3], H[0], H[1], H[2], H[3]}
    od = __builtin_amdgcn_mfma_f32_32x32x16_bf16(pa0, PK(l0, h0), od, 0, 0, 0);
    od = __builtin_amdgcn_mfma_f32_32x32x16_bf16(pa1, PK(l1, h1), od, 0, 0, 0);
    od = __builtin_amdgcn_mfma_f32_32x32x16_bf16(pa2, PK(l2, h2), od, 0, 0, 0);
    od = __builtin_amdgcn_mfma_f32_32x32x16_bf16(pa3, PK(l3, h3), od, 0, 0, 0);
#undef PK
}

__device__ __forceinline__ void attn_unit(char* lds, const int tid, const bf16_t* Qb, bf16_t* Ob, const bf16_t* KVb, int qrow0, int t0, int b, int kvh, const float* sink_l) {
    const int wid = tid >> 6, lane = tid & 63, r32 = lane & 31, hi = lane >> 5;
    char* V_lds = lds; char* K_lds = lds + 2 * SHM_V;
    float* ws = (float*)(lds + 2 * SHM_V + 2 * SHM_K) + wid * 64; float* li_l = ws; float* al_l = ws + 32;
    const int h = kvh * 4 + (wid >> 1);
    const int qoff = (wid & 1) * 32;
    bf16x8 qr[8];
    { const bf16_t* Qw = Qb + (size_t)(qrow0 + qoff + r32) * 1024 + h * 128 + hi * 8;
#pragma unroll
      for (int d0 = 0; d0 < 8; ++d0) qr[d0] = *reinterpret_cast<const bf16x8*>(Qw + d0 * 16); }
    float m_reg = sink_l[h] / SCALE, l_reg = 1.f;
    f32x16 o[4] = {};
    int ks_first = 0, nbt = 0;
    if (t0 >= 0) { ks_first = t0 - 128 < 0 ? 0 : t0 - 128; const int ke = t0 + 192 > SEQ ? SEQ : t0 + 192; nbt = (ke - ks_first) >> 6; }
    const int NT = nbt + 4;
    const int sr = tid >> 4, sc = (tid & 15) * 8, vst0 = v_st(sr, sc), vst1 = v_st(32 + sr, sc);
    const int vb0 = (int)(uintptr_t)V_lds + v_rd_base(lane);
    bf16x8 vs0, vs1, ks0, ks1;
#define TROW(j) ((j) < nbt ? b * SEQ + ks_first + 64 * (j) : ML + b * CTX + 64 * ((j) - nbt))
#define SLOAD(j) do { const bf16_t* kp = KVb + (size_t)(TROW(j) + sr) * 512 + kvh * 128 + sc; \
    ks0 = *reinterpret_cast<const bf16x8*>(kp); ks1 = *reinterpret_cast<const bf16x8*>(kp + 32 * 512); \
    vs0 = *reinterpret_cast<const bf16x8*>(kp + 256); vs1 = *reinterpret_cast<const bf16x8*>(kp + 256 + 32 * 512); } while (0)
#define SWRITE(bu) do { *(bf16x8*)(V_lds + (bu) * SHM_V + vst0) = vs0; *(bf16x8*)(V_lds + (bu) * SHM_V + vst1) = vs1; const int kc = sc * 2; \
    *(bf16x8*)(K_lds + (bu) * SHM_K + KSWZ(sr, kc)) = ks0; *(bf16x8*)(K_lds + (bu) * SHM_K + KSWZ(32 + sr, kc)) = ks1; } while (0)
    SLOAD(0); SWRITE(0); __syncthreads();
    const int qpos = t0 + qoff + r32;
    for (int j = 0; j < NT; ++j) {
        const int bu = j & 1;
        f32x16 p0, p1; float mn, alpha; bf16x8 pa0, pa1, pa2, pa3;
        qkt(p0, p1, K_lds + bu * SHM_K, qr, r32, hi);
        const int kw = ks_first + 64 * j - (t0 + qoff);
        if (j < nbt && (kw + 63 > 128 || kw < -97)) { const int kb = ks_first + 64 * j - qpos;
#pragma unroll
            for (int r = 0; r < 16; ++r) { const int d0 = kb + crow(r, hi), d1 = d0 + 32;
                if (d0 > 128 || d0 < -128) p0[r] = -1e30f; if (d1 > 128 || d1 < -128) p1[r] = -1e30f; } }
        partialSM(p0, p1, m_reg, mn, alpha);
        if (__any(alpha < 1.f)) { if (hi == 0) al_l[r32] = alpha; asm volatile("s_waitcnt lgkmcnt(0)" ::: "memory");
#pragma unroll
            for (int d = 0; d < 4; ++d)
#pragma unroll
                for (int r = 0; r < 16; ++r) o[d][r] *= al_l[crow(r, hi)]; }
        finishSM(p0, p1, alpha, l_reg, pa0, pa1, pa2, pa3); SBAR();
        if (j + 1 < NT) SLOAD(j + 1);
        SBAR();
        const int vb = vb0 + bu * SHM_V;
        pv_one<0>(o[0], vb, pa0, pa1, pa2, pa3); pv_one<1>(o[1], vb, pa0, pa1, pa2, pa3); pv_one<2>(o[2], vb, pa0, pa1, pa2, pa3); pv_one<3>(o[3], vb, pa0, pa1, pa2, pa3);
        if (j + 1 < NT) SWRITE(bu ^ 1);
        __syncthreads();
    }
    if (hi == 0) li_l[r32] = l_reg; asm volatile("s_waitcnt lgkmcnt(0)" ::: "memory");
    bf16_t* Ow = Ob + (size_t)(qrow0 + qoff) * 1024 + h * 128;
#pragma unroll
    for (int r = 0; r < 16; ++r) { const int orow = crow(r, hi); const float rl = __builtin_amdgcn_rcpf(li_l[orow]);
#pragma unroll
        for (int d0 = 0; d0 < 4; ++d0) { const unsigned w = cvt_pk_bf16(o[d0][r] * rl, 0.f); Ow[(size_t)orow * 1024 + d0 * 32 + r32] = (bf16_t)(w & 0xffffu); } }
#undef TROW
#undef SLOAD
#undef SWRITE
}
}

#define XB_TMO      128
#define XB_XCNT(j)  (256  + 64 * (j))
#define XB_XSUB(j)  (1280 + 64 * (j))
#define XB_XGEN(j)  (2304 + 64 * (j))
#define XB_TOP      3328
#define XB_TOPGEN   3392
#define XCD_BAR_WORDS 3456
#define XB_SPIN_CAP (1u << 18)
__device__ __forceinline__ unsigned xb_ld(unsigned* p)              { return __hip_atomic_load(p, __ATOMIC_RELAXED, __HIP_MEMORY_SCOPE_AGENT); }
__device__ __forceinline__ unsigned xb_add(unsigned* p, unsigned v) { return __hip_atomic_fetch_add(p, v, __ATOMIC_RELAXED, __HIP_MEMORY_SCOPE_AGENT); }
__device__ __forceinline__ unsigned xb_xcc_id() { return (unsigned)__builtin_amdgcn_s_getreg((3 << 11) | 20) & 0xFu; }
#define XB_SPIN(cond, bar) do { unsigned _sp = 0; while (cond) { __builtin_amdgcn_s_sleep(1); \
    if ((++_sp & 255u) == 0u) { if (xb_ld(&(bar)[XB_TMO])) break; if (_sp > XB_SPIN_CAP) { atomicAdd(&(bar)[XB_TMO], 1u); break; } } } } while (0)
struct XcdBarrier { unsigned* bar; unsigned x; volatile LAS unsigned* st; };
__device__ __forceinline__ XcdBarrier xcd_barrier_post(unsigned* bar, volatile LAS unsigned* st) {
    XcdBarrier b; b.bar = bar; b.x = xb_xcc_id(); b.st = st;
    if (threadIdx.x == 0) (void)xb_add(&bar[XB_XCNT(b.x)], 1u);
    return b;
}
__device__ __forceinline__ void xcd_barrier_complete(unsigned* bar, unsigned x, unsigned& nloc, unsigned& nx) {
    const unsigned G = gridDim.x * gridDim.y * gridDim.z;
    unsigned sum, cnt, mine, sp = 0u;
    for (;;) {
        sum = 0u; cnt = 0u; mine = 0u;
#pragma unroll
        for (unsigned j = 0; j < 16; ++j) { const unsigned c = xb_ld(&bar[XB_XCNT(j)]); sum += c; cnt += (c > 0u) ? 1u : 0u; mine = (j == x) ? c : mine; }
        if (sum == G) break;
        __builtin_amdgcn_s_sleep(1);
        if ((++sp & 255u) == 0u) { if (xb_ld(&bar[XB_TMO])) break; if (sp > XB_SPIN_CAP) { atomicAdd(&bar[XB_TMO], 1u); break; } }
    }
    nloc = mine > 0u ? mine : 1u; nx = cnt > 0u ? cnt : 1u;
}
__device__ __forceinline__ void xcd_barrier(const XcdBarrier& b) {
    asm volatile("s_waitcnt vmcnt(0)" ::: "memory");
    __syncthreads();
    if (threadIdx.x == 0) {
        unsigned* bar = b.bar;
        __builtin_amdgcn_s_waitcnt(0);
        unsigned nloc = b.st[0], nx = b.st[1];
        if (nloc == 0u) { xcd_barrier_complete(bar, b.x, nloc, nx); b.st[0] = nloc; b.st[1] = nx; }
        const unsigned old = xb_add(&bar[XB_XSUB(b.x)], 1u);
        const unsigned gen = old / nloc;
        if (old + 1u == (gen + 1u) * nloc) {
            __builtin_amdgcn_fence(__ATOMIC_RELEASE, "agent");
            asm volatile("s_waitcnt vmcnt(0)" ::: "memory");
            const unsigned og = xb_add(&bar[XB_TOP], 1u);
            const unsigned tg = og / nx;
            if (og + 1u == (tg + 1u) * nx) xb_add(&bar[XB_TOPGEN], 1u);
            else XB_SPIN(xb_ld(&bar[XB_TOPGEN]) == tg, bar);
            __builtin_amdgcn_fence(__ATOMIC_ACQUIRE, "agent");
            xb_add(&bar[XB_XGEN(b.x)], 1u);
            asm volatile("s_waitcnt vmcnt(0)" ::: "memory");
        } else {
            XB_SPIN(xb_ld(&bar[XB_XGEN(b.x)]) == gen, bar);
            __builtin_amdgcn_fence(__ATOMIC_ACQUIRE, "agent");
            asm volatile("s_waitcnt vmcnt(0)" ::: "memory");
        }
    }
    __syncthreads();
}

struct Params { const float* in[24]; float* out; unsigned char* ws; int ph_lo, ph_hi; };

struct Ctx {
    const Params* p; LAS unsigned char* lds; char* ldsg; int tid, lane, wave, G, bid;
};

__device__ __forceinline__ int rope_perm_col(int c) {
    const int d = c & 63, n = d >> 5, f = d & 31; return (c & ~63) + 32 * (f >> 4) + 8 * ((f >> 2) & 3) + 4 * n + (f & 3);
}
struct TItem { const float* W; bf16_t* WT; int ldw, ldt, k0, n0, drow0, rperm; float scale; };
__device__ __forceinline__ void titem_load(const TItem& t, float (&tv)[32], int lane) {
#pragma unroll
    for (int i = 0; i < 32; ++i) tv[i] = t.scale * t.W[(size_t)(t.k0 + i) * t.ldw + t.n0 + lane];
}
__device__ __forceinline__ void titem_store(const TItem& t, const float (&tv)[32], LAS float* scr, int lane) {
#pragma unroll
    for (int i = 0; i < 32; ++i) scr[i * 65 + lane] = tv[i];
    asm volatile("s_waitcnt lgkmcnt(0)" ::: "memory");
    const int c = lane & 3;
#pragma unroll
    for (int j = 0; j < 4; ++j) { const int n = (lane >> 2) + 16 * j; const LAS float* s = scr + (8 * c) * 65 + n;
        u32x4 o; o.x = cvt_pk_bf16(s[0 * 65], s[1 * 65]); o.y = cvt_pk_bf16(s[2 * 65], s[3 * 65]); o.z = cvt_pk_bf16(s[4 * 65], s[5 * 65]); o.w = cvt_pk_bf16(s[6 * 65], s[7 * 65]);
        const int drow = t.rperm ? rope_perm_col(t.drow0 + n) : t.drow0 + n;
        *(u32x4*)(t.WT + (size_t)drow * t.ldt + t.k0 + 8 * c) = o; }
    asm volatile("s_waitcnt lgkmcnt(0)" ::: "memory");
}
constexpr int WA_ITEMS = 32 * 88 + 3 * 32 * 16 + 256;
__device__ __forceinline__ TItem decode_WA(const Params& P, int l, int it) {
    unsigned char* W = P.ws + OFF_W; TItem t; constexpr int I_IN = 32 * 88, I_SQ = 32 * 16;
    int r = it; t.scale = 1.0f;
    if (r < I_IN) { const int kb = r / 88, nb = r % 88; t.W = P.in[10] + (size_t)l * 1024 * INW; t.ldw = INW; t.k0 = kb * 32; t.n0 = nb * 64; t.WT = (bf16_t*)(W + W_WIN); t.ldt = 1024; t.drow0 = nb * 64; t.rperm = (nb >= 32 && nb < 52) ? 1 : 0; return t; }
    r -= I_IN;
    if (r < 3 * I_SQ) { const int which = r / I_SQ; r %= I_SQ; const int kb = r / 16, nb = r % 16; t.W = P.in[19 + which] + (size_t)l * 1024 * 1024; t.ldw = 1024; t.k0 = kb * 32; t.n0 = nb * 64;
        t.WT = (bf16_t*)(W + (which == 0 ? W_WOR : which == 1 ? W_WOA : W_WOUT)); t.ldt = 1024; t.drow0 = nb * 64; t.rperm = 0; return t; }
    r -= 3 * I_SQ;
    { const int mat = r >> 3, sub = r & 7, kb = sub >> 1, nb = sub & 1; const int dir = mat >> 4, g = (mat >> 3) & 1, blk = mat & 7;
      t.W = P.in[g ? 15 : 13] + ((size_t)(l * 2 + dir) * 8 + blk) * 128 * 128; t.ldw = 128; t.k0 = kb * 32; t.n0 = nb * 64; t.WT = (bf16_t*)(W + W_WG) + (size_t)mat * 128 * 128; t.ldt = 128; t.drow0 = nb * 64; t.rperm = 0; t.scale = -1.4426950408889634f; return t; }
}
constexpr int WF_ITEMS = 32 * 88 + 88 * 16;
__device__ __forceinline__ TItem decode_WF(const Params& P, int l, int it) {
    unsigned char* W = P.ws + OFF_W; TItem t; constexpr int I_FI = 32 * 88;
    int r = it; t.rperm = 0; t.scale = 1.0f;
    if (r < I_FI) { const int kb = r / 88, nb = r % 88; const int n0 = nb * 64; const int up = n0 >= DFF ? 1 : 0, nn = n0 - up * DFF;
        t.W = P.in[22] + (size_t)l * 1024 * INW; t.ldw = INW; t.k0 = kb * 32; t.n0 = n0; t.WT = (bf16_t*)(W + W_WFI); t.ldt = 1024; t.drow0 = 256 * (nn >> 7) + 128 * up + (nn & 127); return t; }
    r -= I_FI;
    { const int kb = r / 16, nb = r % 16; t.W = P.in[23] + (size_t)l * DFF * 1024; t.ldw = 1024; t.k0 = kb * 32; t.n0 = nb * 64; t.WT = (bf16_t*)(W + W_WFO); t.ldt = DFF; t.drow0 = nb * 64; return t; }
}
template <bool FFN>
__device__ __forceinline__ void convert_weights(const Ctx& F, int l) {
    const Params& P = *F.p;
    LAS float* scr = (LAS float*)(F.lds + F.wave * 16384);
    const int gw = F.bid * 8 + F.wave, NGW = F.G * 8; constexpr int NIT = FFN ? WF_ITEMS : WA_ITEMS;
    if (gw >= NIT) return;
    float tva[32], tvb[32];
    TItem ca = FFN ? decode_WF(P, l, gw) : decode_WA(P, l, gw), cb = ca;
    titem_load(ca, tva, F.lane);
    for (int it = gw; it < NIT; it += 2 * NGW) {
        const bool hb = it + NGW < NIT;
        if (hb) { cb = FFN ? decode_WF(P, l, it + NGW) : decode_WA(P, l, it + NGW); titem_load(cb, tvb, F.lane); }
        titem_store(ca, tva, scr, F.lane);
        if (!hb) break;
        const bool ha = it + 2 * NGW < NIT;
        if (ha) { ca = FFN ? decode_WF(P, l, it + 2 * NGW) : decode_WA(P, l, it + 2 * NGW); titem_load(ca, tva, F.lane); }
        titem_store(cb, tvb, scr, F.lane);
        if (!ha) break;
    }
}
__device__ __forceinline__ void convert_WA(const Ctx& F, int l) { convert_weights<false>(F, l); }
__device__ __forceinline__ void convert_WF(const Ctx& F, int l) { convert_weights<true>(F, l); }

__device__ __forceinline__ void mod_phase(const Ctx& F) {
    const Params& P = *F.p; float* MOD = (float*)(P.ws + OFF_MOD);
    LAS float* sv = (LAS float*)F.lds;
    LAS float* red = (LAS float*)(F.lds + 32768);
    if (F.bid >= 192) return;
    for (int i = F.tid; i < 1024; i += 512) {
#pragma unroll
        for (int r = 0; r < 4; ++r) sv[i * 8 + r] = siluf_(P.in[1][r * 1024 + i]);
        sv[i * 8 + 4] = siluf_(P.in[3][i]); sv[i * 8 + 5] = 0.f; sv[i * 8 + 6] = 0.f; sv[i * 8 + 7] = 0.f; }
    __syncthreads();
    for (int it = F.bid; it < 192; it += F.G) {
        const int l = it / 96, n0 = (it % 96) * 64;
        const float* Wm = P.in[4] + (size_t)l * 1024 * 6144 + n0 + F.lane;
        float a0 = 0, a1 = 0, a2 = 0, a3 = 0, a4 = 0;
        const int kb = F.wave * 128;
#pragma unroll 32
        for (int k = 0; k < 128; ++k) { const float w = Wm[(size_t)(kb + k) * 6144]; const LAS float* s = sv + (kb + k) * 8;
            const f32x4 s4 = *(const LAS f32x4*)s; a0 += s4[0] * w; a1 += s4[1] * w; a2 += s4[2] * w; a3 += s4[3] * w; a4 += s[4] * w; }
        red[(F.wave * 5 + 0) * 64 + F.lane] = a0; red[(F.wave * 5 + 1) * 64 + F.lane] = a1; red[(F.wave * 5 + 2) * 64 + F.lane] = a2;
        red[(F.wave * 5 + 3) * 64 + F.lane] = a3; red[(F.wave * 5 + 4) * 64 + F.lane] = a4;
        __syncthreads();
        if (F.wave < 5) { float s = 0;
#pragma unroll
            for (int w = 0; w < 8; ++w) s += red[(w * 5 + F.wave) * 64 + F.lane];
            MOD[(size_t)(l * 5 + F.wave) * 6144 + n0 + F.lane] = s + P.in[5][l * 6144 + n0 + F.lane]; }
        __syncthreads();
    }
}

template <bool BR, bool WH>
__device__ __forceinline__ void norm_phase(const Ctx& F, int nrows, const float* xin_lat, const float* xin_ctx, const bf16_t* branch, const bf16_t* slabs, const float* g_post, const float* mod_g, int gate_off,
                                           float* xout_lat, float* xout_ctx, const float* g_pre, const float* mod_h, int sc_off, int sh_off, bf16_t* Hout) {
    const int gw = F.bid * 8 + F.wave, NGW = F.G * 8, lane = F.lane;
    f32x4 xc[4], xn[4]; u32x2 bc[4], bn[4];
#define NORM_LOAD(row_, X_, B_) do { const int r__ = (row_); const float* xr = r__ < ML ? xin_lat + (size_t)r__ * 1024 : xin_ctx + (size_t)(r__ - ML) * 1024; \
        _Pragma("unroll") for (int j = 0; j < 4; ++j) X_[j] = *(const f32x4*)(xr + 4 * lane + 256 * j); \
        if (BR) { if (slabs != nullptr && r__ >= ML) { _Pragma("unroll") for (int j = 0; j < 4; ++j) { f32x4 a = {0.f, 0.f, 0.f, 0.f}; \
                      _Pragma("unroll") for (int sl = 0; sl < 4; ++sl) { const u32x2 bw = *(const u32x2*)(slabs + (size_t)sl * (1024 * 1024) + (size_t)(r__ - ML) * 1024 + 4 * lane + 256 * j); a = a + (f32x4){bflo(bw.x), bfhi(bw.x), bflo(bw.y), bfhi(bw.y)}; } \
                      B_[j].x = cvt_pk_bf16(a[0], a[1]); B_[j].y = cvt_pk_bf16(a[2], a[3]); } } \
                  else { _Pragma("unroll") for (int j = 0; j < 4; ++j) B_[j] = *(const u32x2*)(branch + (size_t)r__ * 1024 + 4 * lane + 256 * j); } } } while (0)
    if (gw >= nrows) return;
    NORM_LOAD(gw, xc, bc);
    for (int row = gw; row < nrows; row += NGW) {
        const bool hn = row + NGW < nrows;
        if (hn) NORM_LOAD(row + NGW, xn, bn);
        const int mrow = row < ML ? (row >> 12) : 4;
        f32x4 x[4];
#pragma unroll
        for (int j = 0; j < 4; ++j) x[j] = xc[j];
        if (BR) {
            f32x4 m[4]; float s = 0.f;
#pragma unroll
            for (int j = 0; j < 4; ++j) { m[j] = (f32x4){bflo(bc[j].x), bfhi(bc[j].x), bflo(bc[j].y), bfhi(bc[j].y)};
                s += (m[j][0] * m[j][0] + m[j][1] * m[j][1]) + (m[j][2] * m[j][2] + m[j][3] * m[j][3]); }
            const float rs = rsqrtf(wave_sum(s, lane) * (1.f / 1024.f) + EPS);
            float* xo = row < ML ? xout_lat + (size_t)row * 1024 : xout_ctx + (size_t)(row - ML) * 1024;
#pragma unroll
            for (int j = 0; j < 4; ++j) { const f32x4 gp = *(const f32x4*)(g_post + 4 * lane + 256 * j), ga = *(const f32x4*)(mod_g + (size_t)mrow * 6144 + gate_off + 4 * lane + 256 * j);
                x[j] = x[j] + ga * ((m[j] * rs) * gp); *(f32x4*)(xo + 4 * lane + 256 * j) = x[j]; }
        }
        if (WH) {
            float s = 0.f;
#pragma unroll
            for (int j = 0; j < 4; ++j) s += (x[j][0] * x[j][0] + x[j][1] * x[j][1]) + (x[j][2] * x[j][2] + x[j][3] * x[j][3]);
            const float rs = rsqrtf(wave_sum(s, lane) * (1.f / 1024.f) + EPS);
#pragma unroll
            for (int j = 0; j < 4; ++j) { const f32x4 gp = *(const f32x4*)(g_pre + 4 * lane + 256 * j), sc = *(const f32x4*)(mod_h + (size_t)mrow * 6144 + sc_off + 4 * lane + 256 * j),
                    sh = *(const f32x4*)(mod_h + (size_t)mrow * 6144 + sh_off + 4 * lane + 256 * j);
                const f32x4 hv = ((x[j] * rs) * gp) * (sc + 1.0f) + sh;
                u32x2 w; w.x = cvt_pk_bf16(hv[0], hv[1]); w.y = cvt_pk_bf16(hv[2], hv[3]);
                *(u32x2*)(Hout + (size_t)row * 1024 + 4 * lane + 256 * j) = w; }
        }
        if (!hn) break;
#pragma unroll
        for (int j = 0; j < 4; ++j) { xc[j] = xn[j]; bc[j] = bn[j]; }
    }
#undef NORM_LOAD
}

__device__ __forceinline__ void rope_phase(const Ctx& F, bf16_t* Qb, bf16_t* KVb) {
    const int gw = F.bid * 8 + F.wave, NGW = F.G * 8, lane = F.lane;
    const int axis = lane >> 5, f = lane & 31;
    const float inv = exp2f(-(float)f * (13.287712379549449f / 32.0f));
    for (int row = gw; row < ML; row += NGW) {
        const int t = row & (SEQ - 1); const int pos = axis ? (t & 63) : (t >> 6);
        float sn, cs; sincosf((float)pos * inv, &sn, &cs);
        bf16_t* q = Qb + (size_t)row * 1024 + axis * 64 + f;
#pragma unroll
        for (int h = 0; h < 8; ++h) { const float x1 = bf2f(q[h * 128]), x2 = bf2f(q[h * 128 + 32]);
            const unsigned w = cvt_pk_bf16(x1 * cs - x2 * sn, x2 * cs + x1 * sn); q[h * 128] = (bf16_t)(w & 0xffff); q[h * 128 + 32] = (bf16_t)(w >> 16); }
        bf16_t* k = KVb + (size_t)row * 512 + axis * 64 + f;
#pragma unroll
        for (int h = 0; h < 2; ++h) { const float x1 = bf2f(k[h * 128]), x2 = bf2f(k[h * 128 + 32]);
            const unsigned w = cvt_pk_bf16(x1 * cs - x2 * sn, x2 * cs + x1 * sn); k[h * 128] = (bf16_t)(w & 0xffff); k[h * 128 + 32] = (bf16_t)(w >> 16); }
    }
}

constexpr int XT_LD = 136;
constexpr int RG_XT_BYTES = 64 * XT_LD * 2;
constexpr int RG_CW_OFF = RG_XT_BYTES, RG_CW_BYTES = 3072;
constexpr int RG_SC_OFF = RG_CW_OFF + RG_CW_BYTES;
constexpr int RG_SC_BYTES = 16640 + 1152;
template <int PASS>
__device__ __forceinline__ void rglru_phase(const Ctx& F, int l, const bf16_t* XRb, bf16_t* GRb, bool latent_only = false) {
    const Params& P = *F.p;
    const int tid = F.tid, lane = F.lane, wave = F.wave;
    LAS bf16_t* XT = (LAS bf16_t*)F.lds;
    LAS float* CW = (LAS float*)(F.lds + RG_CW_OFF);
    LAS float* SCF = (LAS float*)(F.lds + RG_SC_OFF + wave * RG_SC_BYTES);
    LAS f32x2* AB = (LAS f32x2*)SCF;
    LAS float* CAR = (LAS float*)(F.lds + RG_SC_OFF + wave * RG_SC_BYTES + 16640);
    f32x2* AGG = (f32x2*)(P.ws + OFF_AGG);
    const bf16_t* WgT = (const bf16_t*)(P.ws + OFF_W + W_WG);
    const float* convw = P.in[11] + (size_t)l * 4 * 1024; const float* convb = P.in[12] + (size_t)l * 1024;
    const int cw = wave * 16, l15 = lane & 15, l4 = lane >> 4;
    const int tt = tid >> 3, cs = (tid & 7) * 16;
    for (int su = F.bid; su < 256; su += F.G) {
        const int pair = su >> 3, rg = su & 7, b = pair >> 3, blk = pair & 7;
        const int c0 = latent_only ? 4 + 8 * rg : (rg < 4 ? 9 * rg : 36 + 8 * (rg - 4)), c1 = latent_only ? 12 + 8 * rg : (rg < 3 ? 9 * (rg + 1) : 36 + 8 * (rg - 3));
        __syncthreads();
        for (int i = tid; i < 640; i += 512) CW[i] = i < 512 ? convw[(i >> 7) * 1024 + blk * 128 + (i & 127)] : convb[blk * 128 + (i - 512)];
        bf16x8 Bf[4][4];
#pragma unroll
        for (int gt = 0; gt < 4; ++gt)
#pragma unroll
            for (int ks = 0; ks < 4; ++ks) Bf[gt][ks] = *(const bf16x8*)(WgT + ((size_t)(gt * 8 + blk) * 128 + cw + l15) * 128 + ks * 32 + 8 * l4);
        const int ch = blk * 128 + cw + l15;
        float nba[2], nbx[2], cl2[2];
#pragma unroll
        for (int d = 0; d < 2; ++d) { nba[d] = -1.4426950408889634f * P.in[14][(l * 2 + d) * 1024 + ch]; nbx[d] = -1.4426950408889634f * P.in[16][(l * 2 + d) * 1024 + ch];
            cl2[d] = -8.0f * 1.4426950408889634f * log1pf(__expf(-P.in[17][(l * 2 + d) * 1024 + ch])); }
        if (PASS == 2) {
#pragma unroll 1
            for (int d = 0; d < 2; ++d) {
                __builtin_amdgcn_wave_barrier();
                for (int k = l4; k < NCH; k += 4) AB[k * 16 + l15] = AGG[((size_t)(b * 2 + d) * NCH + k) * 1024 + ch];
                asm volatile("s_waitcnt vmcnt(0) lgkmcnt(0)" ::: "memory"); __builtin_amdgcn_wave_barrier();
                if (lane < 16) { float h = 0.f;
#pragma unroll 4
                    for (int q = 0; q < NCH; ++q) { const int c = d ? (q < 4 ? 3 - q : 71 - q) : q;
                        if (c >= c0 && c < c1) CAR[(d * 9 + (c - c0)) * 16 + lane] = h;
                        const f32x2 ag = AB[c * 16 + lane]; h = ag[0] * h + ag[1]; } }
                asm volatile("s_waitcnt lgkmcnt(0)" ::: "memory"); __builtin_amdgcn_wave_barrier();
            }
        }
        u32x4 xin[4][2];
#define RG_LOADX(c_) do { const int c__ = (c_); const int sr0 = c__ < 4 ? ML + b * CTX : b * SEQ, sl = c__ < 4 ? CTX : SEQ, t0_ = c__ < 4 ? 64 * c__ : 64 * (c__ - 4); \
        _Pragma("unroll") for (int k = 0; k < 4; ++k) { const int tl = t0_ + tt + k - 2; \
            if (tl >= 0 && tl < sl) { const bf16_t* xp = XRb + (size_t)(sr0 + tl) * 1024 + blk * 128 + cs; xin[k][0] = *(const u32x4*)xp; xin[k][1] = *(const u32x4*)(xp + 8); } \
            else { xin[k][0] = (u32x4){0u, 0u, 0u, 0u}; xin[k][1] = (u32x4){0u, 0u, 0u, 0u}; } } } while (0)
        RG_LOADX(c0);
        for (int c = c0; c < c1; ++c) {
            const int seg_row0 = c < 4 ? ML + b * CTX : b * SEQ, tl0 = c < 4 ? 64 * c : 64 * (c - 4);
            __syncthreads();
            {
                float y[16];
#pragma unroll
                for (int e = 0; e < 4; ++e) { const f32x4 bv = *(const LAS f32x4*)(CW + 512 + cs + 4 * e); y[4 * e] = bv[0]; y[4 * e + 1] = bv[1]; y[4 * e + 2] = bv[2]; y[4 * e + 3] = bv[3]; }
#pragma unroll
                for (int k = 0; k < 4; ++k)
#pragma unroll
                    for (int e = 0; e < 4; ++e) { const f32x4 wv = *(const LAS f32x4*)(CW + k * 128 + cs + 4 * e); const unsigned w0 = xin[k][e >> 1][2 * (e & 1)], w1 = xin[k][e >> 1][2 * (e & 1) + 1];
                        y[4 * e] += bflo(w0) * wv[0]; y[4 * e + 1] += bfhi(w0) * wv[1]; y[4 * e + 2] += bflo(w1) * wv[2]; y[4 * e + 3] += bfhi(w1) * wv[3]; }
                u32x4 o0, o1; o0.x = cvt_pk_bf16(y[0], y[1]); o0.y = cvt_pk_bf16(y[2], y[3]); o0.z = cvt_pk_bf16(y[4], y[5]); o0.w = cvt_pk_bf16(y[6], y[7]);
                o1.x = cvt_pk_bf16(y[8], y[9]); o1.y = cvt_pk_bf16(y[10], y[11]); o1.z = cvt_pk_bf16(y[12], y[13]); o1.w = cvt_pk_bf16(y[14], y[15]);
                *(LAS u32x4*)(XT + tt * XT_LD + cs) = o0; *(LAS u32x4*)(XT + tt * XT_LD + cs + 8) = o1;
            }
            __syncthreads();
            if (c + 1 < c1) RG_LOADX(c + 1);
            u32x4 g0, g1;
            if (PASS == 2) { const bf16_t* gp = GRb + (size_t)(seg_row0 + tl0 + lane) * 1024 + blk * 128 + cw; g0 = *(const u32x4*)gp; g1 = *(const u32x4*)(gp + 8); }
            float aggA[2] = {1.f, 1.f}, aggB[2] = {0.f, 0.f};
            float hF = PASS == 2 ? CAR[(0 * 9 + (c - c0)) * 16 + l15] : 0.f;
            float hfv[4][4], ba_[4][4], bb_[4][4], bAe[4], bBe[4], bAt[4], bBt[4];
#pragma unroll
            for (int mt = 0; mt < 4; ++mt) {
                f32x4 ag[4];
#pragma unroll
                for (int gt = 0; gt < 4; ++gt) { const float nb = (gt & 1) ? nbx[gt >> 1] : nba[gt >> 1]; ag[gt] = (f32x4){nb, nb, nb, nb}; }
#pragma unroll
                for (int ks = 0; ks < 4; ++ks) { const bf16x8 af = *(const LAS bf16x8*)(XT + (mt * 16 + l15) * XT_LD + ks * 32 + 8 * l4);
#pragma unroll
                    for (int gt = 0; gt < 4; ++gt) ag[gt] = __builtin_amdgcn_mfma_f32_16x16x32_bf16(af, Bf[gt][ks], ag[gt], 0, 0, 0); }
                float ea[2][4], eb[2][4];
#pragma unroll
                for (int r = 0; r < 4; ++r) { const int tok = mt * 16 + 4 * l4 + r;
                    const float xv = bf2f(XT[tok * XT_LD + cw + l15]);
#pragma unroll
                    for (int d = 0; d < 2; ++d) {
                        const float e1 = 1.0f + __builtin_amdgcn_exp2f(ag[2 * d][r]), e2 = 1.0f + __builtin_amdgcn_exp2f(ag[2 * d + 1][r]);
                        const float inv = __builtin_amdgcn_rcpf(e1 * e2); const float rgate = e2 * inv, igate = e1 * inv;
                        const float a = __builtin_amdgcn_exp2f(rgate * cl2[d]);
                        const float om = fmaf(-a, a, 1.0f);
                        const float bv = __builtin_amdgcn_sqrtf(om) * (igate * xv);
                        ea[d][r] = a; eb[d][r] = bv; } }
                if (PASS == 1) {
#pragma unroll
                    for (int d = 0; d < 2; ++d) {
                        float A, B;
                        if (d == 0) { A = ea[0][0]; B = eb[0][0];
#pragma unroll
                            for (int r = 1; r < 4; ++r) { B = ea[0][r] * B + eb[0][r]; A *= ea[0][r]; } }
                        else { A = ea[1][3]; B = eb[1][3];
#pragma unroll
                            for (int r = 2; r >= 0; --r) { B = ea[1][r] * B + eb[1][r]; A *= ea[1][r]; } }
                        { const float Ap = __uint_as_float(__builtin_amdgcn_ds_bpermute((lane ^ 16) << 2, __float_as_uint(A))), Bp = __uint_as_float(__builtin_amdgcn_ds_bpermute((lane ^ 16) << 2, __float_as_uint(B)));
                          const bool mefirst = d == 0 ? ((l4 & 1) == 0) : ((l4 & 1) == 1);
                          const float nB = mefirst ? Ap * B + Bp : A * Bp + B; A = A * Ap; B = nB; }
                        { const float Ap = __uint_as_float(__builtin_amdgcn_ds_bpermute((lane ^ 32) << 2, __float_as_uint(A))), Bp = __uint_as_float(__builtin_amdgcn_ds_bpermute((lane ^ 32) << 2, __float_as_uint(B)));
                          const bool mefirst = d == 0 ? (l4 < 2) : (l4 >= 2);
                          const float nB = mefirst ? Ap * B + Bp : A * Bp + B; A = A * Ap; B = nB; }
                        if (d == 0) { aggB[0] = A * aggB[0] + B; aggA[0] *= A; }
                        else { aggB[1] = aggA[1] * B + aggB[1]; aggA[1] *= A; }
                    }
                }
                if (PASS == 2) {
#define BPF(src_, v_) __uint_as_float(__builtin_amdgcn_ds_bpermute(((src_) & 63) << 2, __float_as_uint(v_)))
                    {
                        float A = ea[0][0], B = eb[0][0];
#pragma unroll
                        for (int r = 1; r < 4; ++r) { B = ea[0][r] * B + eb[0][r]; A *= ea[0][r]; }
                        { const float Ap = BPF(lane - 16, A), Bp = BPF(lane - 16, B); if (l4 >= 1) { B = A * Bp + B; A = A * Ap; } }
                        { const float Ap = BPF(lane - 32, A), Bp = BPF(lane - 32, B); if (l4 >= 2) { B = A * Bp + B; A = A * Ap; } }
                        const float At = BPF(48 + l15, A), Bt = BPF(48 + l15, B);
                        float Ae = BPF(lane - 16, A), Be = BPF(lane - 16, B); if (l4 == 0) { Ae = 1.f; Be = 0.f; }
                        float h = Ae * hF + Be;
#pragma unroll
                        for (int r = 0; r < 4; ++r) { h = ea[0][r] * h + eb[0][r]; hfv[mt][r] = h; }
                        hF = At * hF + Bt;
                    }
                    {
                        float A = ea[1][3], B = eb[1][3];
#pragma unroll
                        for (int r = 2; r >= 0; --r) { B = ea[1][r] * B + eb[1][r]; A *= ea[1][r]; }
                        { const float Ap = BPF(lane + 16, A), Bp = BPF(lane + 16, B); if (l4 <= 2) { B = A * Bp + B; A = A * Ap; } }
                        { const float Ap = BPF(lane + 32, A), Bp = BPF(lane + 32, B); if (l4 <= 1) { B = A * Bp + B; A = A * Ap; } }
                        bAt[mt] = BPF(l15, A); bBt[mt] = BPF(l15, B);
                        float Ae = BPF(lane + 16, A), Be = BPF(lane + 16, B); if (l4 == 3) { Ae = 1.f; Be = 0.f; }
                        bAe[mt] = Ae; bBe[mt] = Be;
#pragma unroll
                        for (int r = 0; r < 4; ++r) { ba_[mt][r] = ea[1][r]; bb_[mt][r] = eb[1][r]; }
                    }
                }
            }
            if (PASS == 1) { if (lane < 16) { AGG[((size_t)(b * 2 + 0) * NCH + c) * 1024 + ch] = (f32x2){aggA[0], aggB[0]}; AGG[((size_t)(b * 2 + 1) * NCH + c) * 1024 + ch] = (f32x2){aggA[1], aggB[1]}; } }
            asm volatile("s_waitcnt lgkmcnt(0)" ::: "memory"); __builtin_amdgcn_wave_barrier();
            if (PASS == 2) {
                float hB = CAR[(1 * 9 + (c - c0)) * 16 + l15];
#pragma unroll
                for (int mt = 3; mt >= 0; --mt) { float h = bAe[mt] * hB + bBe[mt];
#pragma unroll
                    for (int r = 3; r >= 0; --r) { h = ba_[mt][r] * h + bb_[mt][r]; SCF[(r + 4 * mt + 16 * l4) * 17 + l15] = hfv[mt][r] + h; }
                    hB = bAt[mt] * hB + bBt[mt]; }
                asm volatile("s_waitcnt lgkmcnt(0)" ::: "memory"); __builtin_amdgcn_wave_barrier();
                const size_t go = (size_t)(seg_row0 + tl0 + lane) * 1024 + blk * 128 + cw;
                float u[16];
                const int pl = (lane & 3) + 4 * (lane >> 4) + 16 * ((lane >> 2) & 3);
#pragma unroll
                for (int e = 0; e < 16; ++e) { const float hs = SCF[pl * 17 + e]; const unsigned gw = e < 8 ? g0[e >> 1] : g1[(e - 8) >> 1];
                    u[e] = hs * gelu_tanh((e & 1) ? bfhi(gw) : bflo(gw)); }
                u32x4 o0, o1; o0.x = cvt_pk_bf16(u[0], u[1]); o0.y = cvt_pk_bf16(u[2], u[3]); o0.z = cvt_pk_bf16(u[4], u[5]); o0.w = cvt_pk_bf16(u[6], u[7]);
                o1.x = cvt_pk_bf16(u[8], u[9]); o1.y = cvt_pk_bf16(u[10], u[11]); o1.z = cvt_pk_bf16(u[12], u[13]); o1.w = cvt_pk_bf16(u[14], u[15]);
                *(u32x4*)(GRb + go) = o0; *(u32x4*)(GRb + go + 8) = o1;
            }
            __builtin_amdgcn_wave_barrier();
        }
#undef RG_LOADX
#undef BPF
    }
}

__device__ __forceinline__ void attn_phase(const Ctx& F, int l, const bf16_t* Qb, bf16_t* Ob, const bf16_t* KVb, bool with_ctx) {
    const Params& P = *F.p;
    const int nlat = NB * 2 * 64, nun = nlat + (with_ctx ? NB * 2 * 4 : 0);
    const float* sink = P.in[18] + l * 8;
    for (int u = F.bid; u < nun; u += F.G) {
        if (u < nlat) { const int qb = u & 63, kvh = (u >> 6) & 1, b = u >> 7; att::attn_unit(F.ldsg, F.tid, Qb, Ob, KVb, b * SEQ + qb * 64, qb * 64, b, kvh, sink); }
        else { const int v = u - nlat, cb = v & 3, kvh = (v >> 2) & 1, b = v >> 3; att::attn_unit(F.ldsg, F.tid, Qb, Ob, KVb, ML + b * CTX + cb * 64, -1, b, kvh, sink); }
    }
}

__global__ void __launch_bounds__(512, 2) fwd_kernel(Params prm) {
    extern __shared__ __attribute__((aligned(16))) unsigned char shm[];
    Ctx F; F.p = &prm; F.lds = (LAS unsigned char*)shm; F.ldsg = (char*)shm;
    F.G = gridDim.x; F.bid = blockIdx.x;
    const int wave0 = __builtin_amdgcn_readfirstlane(threadIdx.x >> 6);
    if (threadIdx.x < 16) ((LAS unsigned*)(F.lds + LDS_BARST))[threadIdx.x] = 0u;
    __syncthreads();
    const XcdBarrier xbar = xcd_barrier_post((unsigned*)(prm.ws + OFF_CTL), (volatile LAS unsigned*)(F.lds + LDS_BARST));
    const int lo = prm.ph_lo, hi = prm.ph_hi;
    for (int ph = lo; ph < hi; ++ph) {
        if (ph > lo) { if (lo < 0) cg::this_grid().sync(); else xcd_barrier(xbar); }
        int wv_ = wave0; asm volatile("" : "+s"(wv_));
        int ln_; asm volatile("v_mbcnt_lo_u32_b32 %0, -1, 0\n\tv_mbcnt_hi_u32_b32 %0, -1, %0" : "=v"(ln_));
        F.wave = wv_; F.lane = ln_; F.tid = wv_ * 64 + ln_;
        size_t wz_ = 0; asm volatile("" : "+s"(wz_));
        unsigned char* ws = prm.ws + wz_;
        float* MOD = (float*)(ws + OFF_MOD);
        float* ctxres = (float*)(ws + OFF_CTX);
        bf16_t* GRb = (bf16_t*)(ws + OFF_GR); bf16_t* Qb = (bf16_t*)(ws + OFF_Q); bf16_t* KVb = (bf16_t*)(ws + OFF_KV); bf16_t* GLb = (bf16_t*)(ws + OFF_GL);
        bf16_t* RX = (bf16_t*)(ws + OFF_X); bf16_t* RY = (bf16_t*)(ws + OFF_Y);
        bf16_t* A2 = (bf16_t*)(ws + OFF_A2); bf16_t* Fb = (bf16_t*)(ws + OFF_F); bf16_t* Mx = (bf16_t*)(ws + OFF_MX);
        if (ph == 0) {
            if (F.bid == F.G - 1) { float* TAB = (float*)(ws + OFF_TAB);
                for (int i = F.tid; i < 64 * 32; i += 512) { const int pos = i >> 5, f = i & 31; float sn, cs; sincosf((float)pos * exp2f(-(float)f * (13.287712379549449f / 32.0f)), &sn, &cs); TAB[2 * i] = cs; TAB[2 * i + 1] = sn; } }
            mod_phase(F); __syncthreads(); convert_WA(F, 0); continue; }
        if (ph == 1) { norm_phase<false, true>(F, MT, prm.in[0], prm.in[2], nullptr, nullptr, nullptr, nullptr, 0, nullptr, nullptr, prm.in[6], MOD, 1024, 0, RY); continue; }
        const int l = (ph - 2) / 9, sp = (ph - 2) % 9;
        const bool lastl = (l == 1);
        bf16_t* Hl = l == 0 ? RY : RX; bf16_t* XRb = l == 0 ? RX : RY;
        bf16_t* HF = Hl; bf16_t* Gb = XRb; bf16_t* H2 = RX;
        const int Mg = lastl ? ML : MT;
        const float* xres_lat = l == 0 ? prm.in[0] : prm.out; const float* xres_ctx = l == 0 ? prm.in[2] : ctxres;
        const float* modl = MOD + (size_t)l * 5 * 6144;
        switch (sp) {
        case 0: { pg8::PlainOrder S; S.tm.init(MT, INW, F.G, F.bid); S.A = (const char*)Hl; S.B = (const char*)(ws + OFF_W + W_WIN); S.tsA = (size_t)256 * 1024 * 2; S.tsB = (size_t)256 * 1024 * 2; S.nt = 16;
                  pg8::EpiInProj E{XRb, GRb, Qb, KVb, GLb, (const float*)(ws + OFF_TAB)}; pg8::gemm_phase<false>(F.lds, F.tid, 1024, 1024, 1024, S, E); } break;
        case 1: { rglru_phase<1>(F, l, XRb, GRb); } break;
        case 2: { attn_phase(F, l, Qb, Qb, KVb, !lastl); __syncthreads(); rglru_phase<2>(F, l, XRb, GRb, lastl); } break;
        case 3: { pg8::ChainOrder S; S.tm.init(ML, 1024, F.G, F.bid); S.G = F.G; S.c = F.bid; S.nslice = lastl ? 0 : 64;
                  S.A0 = (const char*)GRb; S.B0 = (const char*)(ws + OFF_W + W_WOR); S.A1 = (const char*)Qb; S.B1 = (const char*)(ws + OFF_W + W_WOA);
                  S.tsA = (size_t)256 * 1024 * 2; S.tsB = (size_t)256 * 1024 * 2; S.nt = 16;
                  pg8::EpiMerge E{GLb, Gb, Hl};
                  pg8::gemm_phase<true>(F.lds, F.tid, 1024, 1024, 1024, S, E); } break;
        case 4: { if (!lastl) {
                      const bf16_t* SLg = Hl; bf16_t* Gc = Gb + (size_t)ML * 1024;
                      for (int i = F.bid * 512 + F.tid; i < 1024 * 1024 / 8; i += F.G * 512) { f32x4 a0 = {0.f, 0.f, 0.f, 0.f}, a1 = a0;
#pragma unroll
                          for (int sl = 0; sl < 4; ++sl) { const u32x4 w = *(const u32x4*)(SLg + (size_t)sl * (1024 * 1024) + (size_t)i * 8);
                              a0 = a0 + (f32x4){bflo(w.x), bfhi(w.x), bflo(w.y), bfhi(w.y)}; a1 = a1 + (f32x4){bflo(w.z), bfhi(w.z), bflo(w.w), bfhi(w.w)}; }
                          u32x4 o; o.x = cvt_pk_bf16(a0[0], a0[1]); o.y = cvt_pk_bf16(a0[2], a0[3]); o.z = cvt_pk_bf16(a1[0], a1[1]); o.w = cvt_pk_bf16(a1[2], a1[3]);
                          *(u32x4*)(Gc + (size_t)i * 8) = o; }
                      xcd_barrier(xbar); }
                  bf16_t* SLm = Mx + (size_t)MT * 1024;
                  pg8::EpiBf16 E{Mx, SLm};
                  pg8::SplitOrder S; S.tm.init(ML, 1024, F.G, F.bid); S.G = F.G; S.c = F.bid; S.nslice = lastl ? 0 : 64; S.A = (const char*)Gb; S.B = (const char*)(ws + OFF_W + W_WOUT); S.tsA = (size_t)256 * 1024 * 2; S.tsB = (size_t)256 * 1024 * 2; S.nt = 16;
                  S.ka = 4; S.kb = 4;
                  pg8::gemm_phase<false>(F.lds, F.tid, 1024, 1024, 1024, S, E); } break;
        case 5: { convert_WF(F, l);
                  norm_phase<true, true>(F, Mg, xres_lat, xres_ctx, Mx, lastl ? nullptr : Mx + (size_t)MT * 1024, prm.in[7] + l * 1024, modl, 2048, prm.out, ctxres, prm.in[8] + l * 1024, modl, 4096, 3072, H2); } break;
        case 6: { pg8::PlainOrder S; S.tm.init(Mg, INW, F.G, F.bid); S.A = (const char*)H2; S.B = (const char*)(ws + OFF_W + W_WFI); S.tsA = (size_t)256 * 1024 * 2; S.tsB = (size_t)256 * 1024 * 2; S.nt = 16;
                  pg8::EpiSwiGLU E{A2}; pg8::gemm_phase<false>(F.lds, F.tid, 1024, 1024, 1024, S, E); } break;
        case 7: { bf16_t* SLf = Fb + (size_t)MT * 1024;
                  pg8::EpiBf16 E{Fb, SLf};
                  pg8::SplitOrder S; S.tm.init(ML, 1024, F.G, F.bid); S.G = F.G; S.c = F.bid; S.nslice = lastl ? 0 : 64; S.A = (const char*)A2; S.B = (const char*)(ws + OFF_W + W_WFO); S.tsA = (size_t)256 * DFF * 2; S.tsB = (size_t)256 * DFF * 2; S.nt = 44;
                  S.ka = 12; S.kb = 10;
                  pg8::gemm_phase<false>(F.lds, F.tid, DFF, DFF, DFF, S, E); } break;
        case 8: { if (!lastl) { convert_WA(F, l + 1);
                      norm_phase<true, true>(F, MT, prm.out, ctxres, Fb, Fb + (size_t)MT * 1024, prm.in[9] + l * 1024, modl, 5120, prm.out, ctxres, prm.in[6] + (l + 1) * 1024, MOD + (size_t)(l + 1) * 5 * 6144, 1024, 0, RX); }
                  else norm_phase<true, false>(F, ML, prm.out, ctxres, Fb, nullptr, prm.in[9] + l * 1024, modl, 5120, prm.out, ctxres, nullptr, nullptr, 0, 0, nullptr); } break;
        }
    }
}

extern "C" void kernel_launch(void* const* d_in, const int* in_sizes, int n_in, void* d_out, int out_size, void* d_ws, size_t ws_size, hipStream_t stream) {
    static int grid = 0;
    if (grid == 0) {
        if (n_in != 24 || out_size != ML * DM || ws_size < WS_END) { fprintf(stderr, "kernel_launch: unexpected shapes (n_in %d out %d ws %zu need %zu)\n", n_in, out_size, ws_size, (size_t)WS_END); grid = -1; return; }
        int dev = 0, cus = 0, per_cu = 0;
        hipGetDevice(&dev); hipDeviceGetAttribute(&cus, hipDeviceAttributeMultiprocessorCount, dev);
        if (hipFuncSetAttribute((const void*)fwd_kernel, hipFuncAttributeMaxDynamicSharedMemorySize, LDS_BYTES) != hipSuccess) { fprintf(stderr, "kernel_launch: hipFuncSetAttribute failed\n"); grid = -1; return; }
        if (hipOccupancyMaxActiveBlocksPerMultiprocessor(&per_cu, (const void*)fwd_kernel, 512, LDS_BYTES) != hipSuccess || per_cu < 1) { fprintf(stderr, "kernel_launch: occupancy query gave %d\n", per_cu); per_cu = 1; }
        (void)hipGetLastError();
        grid = cus * (per_cu > 1 ? 1 : per_cu);
        fprintf(stderr, "kernel_launch: grid %d (cus %d per_cu %d)\n", grid, cus, per_cu);
    }
    if (grid < 0) return;
    Params p{};
    for (int i = 0; i < 24; ++i) p.in[i] = (const float*)d_in[i];
    p.out = (float*)d_out; p.ws = (unsigned char*)d_ws;
    if (hipMemsetAsync((char*)d_ws + OFF_CTL, 0, CTL_BYTES, stream) != hipSuccess) { fprintf(stderr, "kernel_launch: memset failed\n"); return; }
#if MK_PER_PHASE
    for (int ph = 0; ph < NPHASE; ++ph) { p.ph_lo = ph; p.ph_hi = ph + 1; hipLaunchKernelGGL(fwd_kernel, dim3(grid), dim3(512), LDS_BYTES, stream, p); }
#else
    p.ph_lo = 0; p.ph_hi = NPHASE;
    void* args[] = {&p};
    hipError_t e = hipLaunchCooperativeKernel((const void*)fwd_kernel, dim3(grid), dim3(512), args, LDS_BYTES, stream);
    if (e != hipSuccess) fprintf(stderr, "kernel_launch: cooperative launch failed: %s (grid %d)\n", hipGetErrorString(e), grid);
#endif
}
```

```cpp
#include <hip/hip_runtime.h>
#include <hip/hip_cooperative_groups.h>
#include <cstdio>
#include <cstdint>
namespace cg = cooperative_groups;

#ifndef MK_PER_PHASE
#define MK_PER_PHASE 0
#endif

#define LAS __attribute__((address_space(3)))
typedef unsigned short bf16_t;
typedef short bf16x8 __attribute__((ext_vector_type(8)));
typedef short s16x4 __attribute__((ext_vector_type(4)));
typedef float f32x4 __attribute__((ext_vector_type(4)));
typedef float f32x2 __attribute__((ext_vector_type(2)));
typedef float f32x16 __attribute__((ext_vector_type(16)));
typedef unsigned u32x4 __attribute__((ext_vector_type(4)));
typedef unsigned u32x2 __attribute__((ext_vector_type(2)));

constexpr int DM = 1024, NB = 4, SEQ = 4096, CTX = 256;
constexpr int ML = NB * SEQ, MC = NB * CTX, MT = ML + MC;
constexpr int INW = 5632, DFF = 2816, NCH = 68;
constexpr float EPS = 1e-6f;
constexpr int NPHASE = 20;

constexpr size_t MB1 = (size_t)MT * 1024 * 2;
constexpr size_t OFF_W = 0;
constexpr size_t W_WIN = 0, W_WG = 11534336, W_WOR = W_WG + 1048576, W_WOA = W_WOR + 2097152, W_WOUT = W_WOA + 2097152;
constexpr size_t W_WFI = 0, W_WFO = 11534336;
constexpr size_t OFF_CTX = 18874368;
constexpr size_t OFF_MOD = OFF_CTX + 4194304;
constexpr size_t OFF_AGG = OFF_MOD + 245760;
constexpr size_t OFF_X = OFF_AGG + 4456448;
constexpr size_t OFF_GR = OFF_X + MB1;
constexpr size_t OFF_Q = OFF_GR + MB1;
constexpr size_t OFF_KV = OFF_Q + MB1;
constexpr size_t OFF_GL = OFF_KV + (size_t)MT * 512 * 2;
constexpr size_t OFF_Y = OFF_GL + (size_t)MT * 2048 * 2;
constexpr size_t OFF_CTL = OFF_Y + MB1, CTL_BYTES = 16384;
constexpr size_t OFF_TAB = OFF_CTL + CTL_BYTES, TAB_BYTES = 64 * 32 * 8;
constexpr size_t WS_END = OFF_TAB + TAB_BYTES;
constexpr size_t OFF_A2 = OFF_GR;
constexpr size_t OFF_F = OFF_CTL - (size_t)MT * 1024 * 4;
constexpr size_t OFF_MX = OFF_GL;
static_assert(OFF_A2 + (size_t)MT * DFF * 2 <= OFF_F, "A2/F overlap");
static_assert(WS_END <= 268435456, "workspace");

constexpr int LDS_BYTES = 163840;
constexpr int LDS_BARST = LDS_BYTES - 64;

__device__ __forceinline__ unsigned cvt_pk_bf16(float lo, float hi) { unsigned r; asm volatile("v_cvt_pk_bf16_f32 %0, %1, %2" : "=v"(r) : "v"(lo), "v"(hi)); return r; }
__device__ __forceinline__ float bf2f(unsigned short v) { return __uint_as_float(((unsigned)v) << 16); }
__device__ __forceinline__ float bflo(unsigned w) { return __uint_as_float(w << 16); }
__device__ __forceinline__ float bfhi(unsigned w) { return __uint_as_float(w & 0xffff0000u); }
__device__ __forceinline__ float sigmoidf_(float x) { return __builtin_amdgcn_rcpf(1.0f + __expf(-x)); }
__device__ __forceinline__ float siluf_(float x) { return x * __builtin_amdgcn_rcpf(1.0f + __expf(-x)); }
__device__ __forceinline__ float gelu_tanh(float x) { const float u = 0.7978845608028654f * (x + 0.044715f * x * x * x); const float t = 1.0f - 2.0f * __builtin_amdgcn_rcpf(1.0f + __expf(2.0f * u)); return 0.5f * x * (1.0f + t); }
__device__ __forceinline__ float wave_sum(float v, int lane) {
#pragma unroll
    for (int o = 1; o < 64; o <<= 1) v += __uint_as_float(__builtin_amdgcn_ds_bpermute((lane ^ o) << 2, __float_as_uint(v)));
    return v;
}

namespace pg8 {
constexpr int BM = 256, BK = 64, HALF = 128, HTB = HALF * BK * 2, STAGE_BYTES = 8 * HTB, NXCD = 8, WGM = 8;
__device__ __forceinline__ int lds_byte(int r, int c) { const int st = (r >> 4) * 2 + (c >> 5), rr = r & 15, cc = c & 31, ob = rr * 64 + cc * 2; return st * 1024 + (ob ^ (((ob >> 9) & 1) << 5)); }
__device__ __forceinline__ void stage_rc(int b, int& R, int& C) { const int st = b / 1024, sb = b % 1024, swz = sb ^ (((sb >> 9) & 1) << 5); R = (st >> 1) * 16 + swz / 64; C = (st & 1) * 32 + (swz % 64) / 2; }
__device__ __forceinline__ int perm32(int rho) { const int n = rho >> 4, i = rho & 15; return 8 * (i >> 2) + 4 * n + (i & 3); }

struct Unit { int pm, pn; const char* A; const char* B; int chain; int nt; int slab; };

struct TileMap {
    int nM, nN, nwg, G, c;
    __device__ void init(int M, int N, int G_, int c_) { nM = M / BM; nN = N / BM; nwg = nM * nN; G = G_; c = c_; }
    __device__ bool tile(int i, int& pm, int& pn) const {
        const long L = (long)i * G + c; if (L >= nwg) return false;
        int wgid = (int)L; { const int q = nwg / NXCD, r = nwg % NXCD, xcd = wgid % NXCD, off = wgid / NXCD; wgid = (xcd < r ? xcd * (q + 1) : r * (q + 1) + (xcd - r) * q) + off; }
        const int nig = WGM * nN, gid = wgid / nig, fm = gid * WGM, gsz = (nM - fm) < WGM ? (nM - fm) : WGM;
        pm = fm + ((wgid % nig) % gsz); pn = (wgid % nig) / gsz; return true;
    }
};
struct PlainOrder {
    TileMap tm; const char* A; const char* B; size_t tsA, tsB; int nt;
    __device__ bool next(int i, Unit& u) const { if (!tm.tile(i, u.pm, u.pn)) return false; u.A = A + (size_t)u.pm * tsA; u.B = B + (size_t)u.pn * tsB; u.chain = 0; u.nt = nt; u.slab = -1; return true; }
};
struct SplitOrder {
    TileMap tm; const char* A; const char* B; size_t tsA, tsB; int nt; int G, c; int nslice; int ka, kb;
    __device__ bool next(int i, Unit& u) const {
        const long L = (long)i * G + c;
        if (L < 256) { if (!tm.tile(i, u.pm, u.pn)) return false; u.A = A + (size_t)u.pm * tsA; u.B = B + (size_t)u.pn * tsB; u.chain = 0; u.nt = nt; u.slab = -1; return true; }
        const int j = (int)(L - 256); if (j >= nslice) return false;
        const int t = j >> 2, sl = j & 3; u.pm = 64 + (t >> 2); u.pn = t & 3; u.chain = 0; u.slab = sl;
        const int kk = sl < 2 ? ka * sl : 2 * ka + kb * (sl - 2); u.nt = sl < 2 ? ka : kb;
        u.A = A + (size_t)u.pm * tsA + (size_t)kk * 128; u.B = B + (size_t)u.pn * tsB + (size_t)kk * 128; return true;
    }
};
struct ChainOrder {
    TileMap tm; const char* A0; const char* B0; const char* A1; const char* B1; size_t tsA, tsB; int nt; int G, c, nslice;
    __device__ bool next(int i, Unit& u) const { const int part = i & 1; u.chain = part ? 0 : 1;
        if (nslice == 0) { if (!tm.tile(i >> 1, u.pm, u.pn)) return false; u.nt = nt; u.slab = -1;
            u.A = (part ? A1 : A0) + (size_t)u.pm * tsA; u.B = (part ? B1 : B0) + (size_t)u.pn * tsB; return true; }
        const long L = (long)(i >> 1) * G + c;
        if (L < 256) { if (!tm.tile(i >> 1, u.pm, u.pn)) return false; u.nt = nt; u.slab = -1;
            u.A = (part ? A1 : A0) + (size_t)u.pm * tsA; u.B = (part ? B1 : B0) + (size_t)u.pn * tsB; return true; }
        const int j = (int)(L - 256); if (j >= nslice) return false;
        const int t = j >> 2, sl = j & 3; u.pm = 64 + (t >> 2); u.pn = t & 3; u.slab = sl; u.nt = 4;
        u.A = (part ? A1 : A0) + (size_t)u.pm * tsA + (size_t)sl * 512; u.B = (part ? B1 : B0) + (size_t)u.pn * tsB + (size_t)sl * 512; return true; }
};

template <bool CHAIN, class Epi, class Sched>
__device__ __forceinline__ void gemm_phase(LAS unsigned char* lds, const int tid, const int K, const int lda, const int ldb, const Sched& S, const Epi& E) {
    const int wid = __builtin_amdgcn_readfirstlane(tid >> 6), lane = tid & 63, wr = wid >> 2, wc = wid & 3, fr = lane & 15, fq = lane >> 4;
    unsigned voffA[2], voffB[2];
#pragma unroll
    for (int i = 0; i < 2; ++i) { int R, C; stage_rc(tid * 16 + i * 8192, R, C); const int Rb = Epi::PERM ? ((R & ~31) + perm32(R & 31)) : R;
        voffA[i] = (unsigned)(R * lda + C) * 2u; voffB[i] = (unsigned)(Rb * ldb + C) * 2u; }
    const size_t kstep = (size_t)(BK * 2);
    const size_t hstepA = (size_t)HALF * lda * 2, hstepB = (size_t)HALF * ldb * 2;
    const unsigned ldsw = (unsigned)wid * 1024u;
    const int aoff = lds_byte(wr * 64 + fr, fq * 8), boff = lds_byte(wc * 32 + fr, fq * 8);
#define PG8_SA(b, h) (((b) * 2 + (h)) * HTB)
#define PG8_SB(b, h) ((4 + (b) * 2 + (h)) * HTB)
#define PG8_STAGE(bufoff, gbase, voff) do { _Pragma("unroll") for (int _i = 0; _i < 2; ++_i) \
        __builtin_amdgcn_global_load_lds((const unsigned*)((const char*)(gbase) + (voff)[_i]), (LAS unsigned*)(lds + (bufoff) + ldsw + _i * 8192), 16, 0, 0); } while (0)
#define PG8_LDA(dst, b, h) do { _Pragma("unroll") for (int m = 0; m < 4; ++m) _Pragma("unroll") for (int k = 0; k < 2; ++k) dst[m][k] = *(const LAS bf16x8*)(lds + PG8_SA(b, h) + aoff + m * 2048 + k * 1024); } while (0)
#define PG8_LDB(dst, b, h) do { _Pragma("unroll") for (int n = 0; n < 2; ++n) _Pragma("unroll") for (int k = 0; k < 2; ++k) dst[n][k] = *(const LAS bf16x8*)(lds + PG8_SB(b, h) + boff + n * 2048 + k * 1024); } while (0)
#define PG8_MMA(ai, bj, At, Bt) do { __builtin_amdgcn_s_setprio(1); _Pragma("unroll") for (int m = 0; m < 4; ++m) _Pragma("unroll") for (int n = 0; n < 2; ++n) _Pragma("unroll") for (int k = 0; k < 2; ++k) \
        acc[ai][bj][m][n] = __builtin_amdgcn_mfma_f32_16x16x32_bf16(Bt[n][k], At[m][k], acc[ai][bj][m][n], 0, 0, 0); __builtin_amdgcn_s_setprio(0); } while (0)
#define PG8_WAIT_V(n) asm volatile("s_waitcnt vmcnt(" #n ")" ::: "memory")
#define PG8_WAIT_L(n) asm volatile("s_waitcnt lgkmcnt(" #n ")" ::: "memory")
#define PG8_BAR __builtin_amdgcn_s_barrier()
#define PG8_SCHED __builtin_amdgcn_sched_barrier(0)
#define PG8_KLOOP(cA_, cB_, nA_, nB_, nt_) do { const int nt__ = (nt_); \
        for (int t = 0; t < nt__; t += 2) { \
            const bool last = (t == nt__ - 2); \
            const char* a1 = (cA_) + (size_t)(t + 1) * kstep; \
            const char* a2 = last ? (nA_) : (cA_) + (size_t)(t + 2) * kstep; const char* b2 = last ? (nB_) : (cB_) + (size_t)(t + 2) * kstep; \
            const char* a3 = a2 + kstep; const char* b3 = b2 + kstep; \
            PG8_LDB(B0, 0, 0); PG8_LDB(B1, 0, 1); PG8_SCHED; PG8_LDA(At, 0, 0); PG8_STAGE(PG8_SA(1, 1), a1 + hstepA, voffA); \
            PG8_WAIT_V(8); PG8_WAIT_L(0); PG8_BAR; PG8_MMA(0, 0, At, B0); PG8_MMA(0, 1, At, B1); PG8_BAR; PG8_SCHED; \
            PG8_LDA(At, 0, 1); PG8_STAGE(PG8_SB(0, 0), b2, voffB); PG8_STAGE(PG8_SB(0, 1), b2 + hstepB, voffB); PG8_STAGE(PG8_SA(0, 0), a2, voffA); \
            PG8_WAIT_V(8); PG8_WAIT_L(0); PG8_BAR; PG8_MMA(1, 0, At, B0); PG8_MMA(1, 1, At, B1); PG8_BAR; PG8_SCHED; \
            PG8_LDB(B0, 1, 0); PG8_LDB(B1, 1, 1); PG8_SCHED; PG8_LDA(At, 1, 0); PG8_STAGE(PG8_SA(0, 1), a2 + hstepA, voffA); \
            PG8_WAIT_V(8); PG8_WAIT_L(0); PG8_BAR; PG8_MMA(0, 0, At, B0); PG8_MMA(0, 1, At, B1); PG8_BAR; PG8_SCHED; \
            PG8_LDA(At, 1, 1); PG8_STAGE(PG8_SB(1, 0), b3, voffB); PG8_STAGE(PG8_SB(1, 1), b3 + hstepB, voffB); PG8_STAGE(PG8_SA(1, 0), a3, voffA); \
            PG8_WAIT_V(8); PG8_WAIT_L(0); PG8_BAR; PG8_MMA(1, 0, At, B0); PG8_MMA(1, 1, At, B1); PG8_BAR; PG8_SCHED; \
        } } while (0)
#define PG8_EPI_IDS int l2_ = lane; asm volatile("" : "+v"(l2_)); const int fr2 = l2_ & 15, fq2 = l2_ >> 4
    Unit cur, nxt; int ui = 0;
    if (!S.next(0, cur)) return;
    f32x4 acc[2][2][4][2];
#pragma unroll
    for (int a = 0; a < 2; ++a)
#pragma unroll
        for (int b = 0; b < 2; ++b)
#pragma unroll
            for (int m = 0; m < 4; ++m)
#pragma unroll
                for (int n = 0; n < 2; ++n) acc[a][b][m][n] = (f32x4){0.f, 0.f, 0.f, 0.f};
    bf16x8 At[4][2], B0[2][2], B1[2][2];
    {
        const char* cA = cur.A; const char* cB = cur.B;
        PG8_STAGE(PG8_SB(0, 0), cB, voffB); PG8_STAGE(PG8_SB(0, 1), cB + hstepB, voffB); PG8_STAGE(PG8_SA(0, 0), cA, voffA); PG8_STAGE(PG8_SA(0, 1), cA + hstepA, voffA);
        if (wr == 1) PG8_BAR;
        PG8_WAIT_V(2); PG8_BAR;
        PG8_STAGE(PG8_SB(1, 0), cB + kstep, voffB); PG8_STAGE(PG8_SA(1, 0), cA + kstep, voffA); PG8_STAGE(PG8_SB(1, 1), cB + hstepB + kstep, voffB);
        PG8_WAIT_V(6); PG8_BAR;
    }
    for (;;) {
        bool has_next;
        if constexpr (CHAIN) {
            Unit c2; (void)S.next(ui + 1, c2);
            PG8_KLOOP(cur.A, cur.B, c2.A, c2.B, cur.nt);
            if (wr == 0) PG8_BAR;
            { PG8_EPI_IDS; E.mid(acc, cur, wr, wc, fr2, fq2); }
            if (wr == 1) PG8_BAR;
            ++ui;
            has_next = S.next(ui + 1, nxt);
            const char* nA = has_next ? nxt.A : c2.A; const char* nB = has_next ? nxt.B : c2.B;
            PG8_KLOOP(c2.A, c2.B, nA, nB, c2.nt);
            if (wr == 0) PG8_BAR;
            { PG8_EPI_IDS; E(acc, c2, wr, wc, fr2, fq2); }
        } else {
            has_next = S.next(ui + 1, nxt);
            const char* nA = has_next ? nxt.A : cur.A; const char* nB = has_next ? nxt.B : cur.B;
            PG8_KLOOP(cur.A, cur.B, nA, nB, cur.nt);
            if (wr == 0) PG8_BAR;
            { PG8_EPI_IDS; E(acc, cur, wr, wc, fr2, fq2); }
        }
        if (!has_next) break;
#pragma unroll
        for (int a = 0; a < 2; ++a)
#pragma unroll
            for (int b = 0; b < 2; ++b)
#pragma unroll
                for (int m = 0; m < 4; ++m)
#pragma unroll
                    for (int n = 0; n < 2; ++n) acc[a][b][m][n] = (f32x4){0.f, 0.f, 0.f, 0.f};
        cur = nxt; ++ui;
        if (wr == 1) PG8_BAR;
    }
    PG8_WAIT_V(0);
    PG8_BAR;
#undef PG8_SA
#undef PG8_SB
#undef PG8_STAGE
#undef PG8_LDA
#undef PG8_LDB
#undef PG8_MMA
#undef PG8_WAIT_V
#undef PG8_WAIT_L
#undef PG8_BAR
#undef PG8_SCHED
#undef PG8_KLOOP
#undef PG8_EPI_IDS
}

struct EpiInProj {
    static constexpr bool PERM = true;
    bf16_t *XR, *GR, *Q, *KV, *GL; const float* TAB;
    __device__ __forceinline__ void mid(f32x4 (&acc)[2][2][4][2], const Unit& u, int wr, int wc, int fr, int fq) const {}
    template <int LDC> __device__ __forceinline__ void store(const f32x4 (&acc)[2][2][4][2], bf16_t* base, int row0) const {
        bf16_t* rp = base + (size_t)row0 * LDC;
#pragma unroll
        for (int ai = 0; ai < 2; ++ai)
#pragma unroll
            for (int m = 0; m < 4; ++m) { bf16_t* rowp = rp + (size_t)(ai * HALF + m * 16) * LDC;
#pragma unroll
                for (int bj = 0; bj < 2; ++bj) { const f32x4 v0 = acc[ai][bj][m][0], v1 = acc[ai][bj][m][1];
                    u32x4 w; w.x = cvt_pk_bf16(v0[0], v0[1]); w.y = cvt_pk_bf16(v0[2], v0[3]); w.z = cvt_pk_bf16(v1[0], v1[1]); w.w = cvt_pk_bf16(v1[2], v1[3]);
                    *(u32x4*)(rowp + bj * HALF) = w; } }
    }
    template <int LDC> __device__ __forceinline__ void store_rope(const f32x4 (&acc)[2][2][4][2], bf16_t* base, int row0, int wc, int fq) const {
        bf16_t* rp = base + (size_t)row0 * LDC; const int axis = wc >> 1, f0 = 16 * (wc & 1) + 4 * fq;
#pragma unroll
        for (int ai = 0; ai < 2; ++ai)
#pragma unroll
            for (int m = 0; m < 4; ++m) { const int row = row0 + ai * HALF + m * 16; bf16_t* rowp = rp + (size_t)(ai * HALF + m * 16) * LDC;
                const int t = row & (SEQ - 1), pos = axis ? (t & 63) : (t >> 6);
                f32x4 cs0 = *(const f32x4*)(TAB + (pos * 32 + f0) * 2), cs1 = *(const f32x4*)(TAB + (pos * 32 + f0) * 2 + 4);
                if (row >= ML) { cs0 = (f32x4){1.f, 0.f, 1.f, 0.f}; cs1 = cs0; }
#pragma unroll
                for (int bj = 0; bj < 2; ++bj) { const f32x4 x1 = acc[ai][bj][m][0], x2 = acc[ai][bj][m][1];
                    u32x4 w;
                    w.x = cvt_pk_bf16(x1[0] * cs0[0] - x2[0] * cs0[1], x1[1] * cs0[2] - x2[1] * cs0[3]);
                    w.y = cvt_pk_bf16(x1[2] * cs1[0] - x2[2] * cs1[1], x1[3] * cs1[2] - x2[3] * cs1[3]);
                    w.z = cvt_pk_bf16(x2[0] * cs0[0] + x1[0] * cs0[1], x2[1] * cs0[2] + x1[1] * cs0[3]);
                    w.w = cvt_pk_bf16(x2[2] * cs1[0] + x1[2] * cs1[1], x2[3] * cs1[2] + x1[3] * cs1[3]);
                    *(u32x4*)(rowp + bj * HALF) = w; } }
    }
    __device__ __forceinline__ void operator()(const f32x4 (&acc)[2][2][4][2], const Unit& u, int wr, int wc, int fr, int fq) const {
        const int pn = u.pn; const int row0 = u.pm * BM + wr * 64 + fr, col0 = wc * 32 + 8 * fq;
        if (pn < 8) { bf16_t* base = (pn < 4 ? XR + pn * 256 : GR + (pn - 4) * 256) + col0; store<1024>(acc, base, row0); }
        else if (pn < 12) { store_rope<1024>(acc, Q + (pn - 8) * 256 + col0, row0, wc, fq); }
        else if (pn == 12) { store_rope<512>(acc, KV + col0, row0, wc, fq); }
        else if (pn == 13) { store<512>(acc, KV + 256 + col0, row0); }
        else { store<2048>(acc, GL + (pn - 14) * 256 + col0, row0); }
    }
};
struct EpiSwiGLU {
    static constexpr bool PERM = true;
    bf16_t* O;
    __device__ __forceinline__ void mid(f32x4 (&acc)[2][2][4][2], const Unit& u, int wr, int wc, int fr, int fq) const {}
    __device__ __forceinline__ void operator()(const f32x4 (&acc)[2][2][4][2], const Unit& u, int wr, int wc, int fr, int fq) const {
        const int row0 = u.pm * BM + wr * 64 + fr, col0 = u.pn * 128 + wc * 32 + 8 * fq;
#pragma unroll
        for (int ai = 0; ai < 2; ++ai)
#pragma unroll
            for (int m = 0; m < 4; ++m) { bf16_t* rowp = O + (size_t)(row0 + ai * HALF + m * 16) * DFF + col0;
                float r[8];
#pragma unroll
                for (int n = 0; n < 2; ++n)
#pragma unroll
                    for (int j = 0; j < 4; ++j) r[n * 4 + j] = siluf_(acc[ai][0][m][n][j]) * acc[ai][1][m][n][j];
                u32x4 w; w.x = cvt_pk_bf16(r[0], r[1]); w.y = cvt_pk_bf16(r[2], r[3]); w.z = cvt_pk_bf16(r[4], r[5]); w.w = cvt_pk_bf16(r[6], r[7]);
                *(u32x4*)rowp = w; }
    }
};
struct EpiMerge {
    static constexpr bool PERM = true;
    const bf16_t* GL; bf16_t* G; bf16_t* SL;
    __device__ __forceinline__ void mid(f32x4 (&acc)[2][2][4][2], const Unit& u, int wr, int wc, int fr, int fq) const {
        const int row0 = u.pm * BM + wr * 64 + fr, col0 = u.pn * BM + wc * 32 + 8 * fq;
#pragma unroll
        for (int ai = 0; ai < 2; ++ai)
#pragma unroll
            for (int m = 0; m < 4; ++m) { const bf16_t* gp = GL + (size_t)(row0 + ai * HALF + m * 16) * 2048 + col0;
#pragma unroll
                for (int bj = 0; bj < 2; ++bj) { const u32x4 la = *(const u32x4*)(gp + bj * HALF), lb = *(const u32x4*)(gp + 1024 + bj * HALF);
#pragma unroll
                    for (int n = 0; n < 2; ++n)
#pragma unroll
                        for (int j = 0; j < 4; ++j) { const int e = n * 4 + j; const unsigned wa = la[e >> 1], wb = lb[e >> 1];
                            const float a = (e & 1) ? bfhi(wa) : bflo(wa), b = (e & 1) ? bfhi(wb) : bflo(wb);
                            acc[ai][bj][m][n][j] *= (1.0f + __expf(-b)) * __builtin_amdgcn_rcpf(1.0f + __expf(-a)); }
                    asm volatile("" : "+v"(acc[ai][bj][m][0]), "+v"(acc[ai][bj][m][1]) :: "memory"); } }
    }
    __device__ __forceinline__ void operator()(const f32x4 (&acc)[2][2][4][2], const Unit& u, int wr, int wc, int fr, int fq) const {
        const int row0 = u.pm * BM + wr * 64 + fr, col0 = u.pn * BM + wc * 32 + 8 * fq;
        bf16_t* gout = u.slab < 0 ? G : SL + (size_t)u.slab * (1024 * 1024) - (size_t)ML * 1024;
#pragma unroll
        for (int ai = 0; ai < 2; ++ai)
#pragma unroll
            for (int m = 0; m < 4; ++m) { const size_t r = (size_t)(row0 + ai * HALF + m * 16);
#pragma unroll
                for (int bj = 0; bj < 2; ++bj) { const u32x4 lb = *(const u32x4*)(GL + r * 2048 + 1024 + col0 + bj * HALF); float o[8];
#pragma unroll
                    for (int n = 0; n < 2; ++n)
#pragma unroll
                        for (int j = 0; j < 4; ++j) { const int e = n * 4 + j; const unsigned wb = lb[e >> 1]; const float b = (e & 1) ? bfhi(wb) : bflo(wb);
                            o[e] = acc[ai][bj][m][n][j] * __builtin_amdgcn_rcpf(1.0f + __expf(-b)); }
                    u32x4 w; w.x = cvt_pk_bf16(o[0], o[1]); w.y = cvt_pk_bf16(o[2], o[3]); w.z = cvt_pk_bf16(o[4], o[5]); w.w = cvt_pk_bf16(o[6], o[7]);
                    *(u32x4*)(gout + r * 1024 + col0 + bj * HALF) = w; asm volatile("" ::: "memory"); } }
    }
};
struct EpiBf16 {
    static constexpr bool PERM = true;
    bf16_t* O; bf16_t* SL;
    __device__ __forceinline__ void mid(f32x4 (&acc)[2][2][4][2], const Unit& u, int wr, int wc, int fr, int fq) const {}
    __device__ __forceinline__ void operator()(const f32x4 (&acc)[2][2][4][2], const Unit& u, int wr, int wc, int fr, int fq) const {
        const int row0 = u.pm * BM + wr * 64 + fr, col0 = u.pn * BM + wc * 32 + 8 * fq;
        bf16_t* ob = u.slab < 0 ? O : SL + (size_t)u.slab * (1024 * 1024) - (size_t)ML * 1024;
#pragma unroll
        for (int ai = 0; ai < 2; ++ai)
#pragma unroll
            for (int m = 0; m < 4; ++m) { bf16_t* rowp = ob + (size_t)(row0 + ai * HALF + m * 16) * 1024 + col0;
#pragma unroll
                for (int bj = 0; bj < 2; ++bj) { const f32x4 v0 = acc[ai][bj][m][0], v1 = acc[ai][bj][m][1];
                    u32x4 w; w.x = cvt_pk_bf16(v0[0], v0[1]); w.y = cvt_pk_bf16(v0[2], v0[3]); w.z = cvt_pk_bf16(v1[0], v1[1]); w.w = cvt_pk_bf16(v1[2], v1[3]);
                    *(u32x4*)(rowp + bj * HALF) = w; } }
    }
};
struct EpiF32 {
    static constexpr bool PERM = false;
    float* O;
    __device__ __forceinline__ void mid(f32x4 (&acc)[2][2][4][2], const Unit& u, int wr, int wc, int fr, int fq) const {}
    __device__ __forceinline__ void operator()(const f32x4 (&acc)[2][2][4][2], const Unit& u, int wr, int wc, int fr, int fq) const {
        const int row0 = u.pm * BM + wr * 64 + fr, col0 = u.pn * BM + wc * 32 + 4 * fq;
#pragma unroll
        for (int ai = 0; ai < 2; ++ai)
#pragma unroll
            for (int m = 0; m < 4; ++m) { float* rowp = O + (size_t)(row0 + ai * HALF + m * 16) * 1024 + col0;
#pragma unroll
                for (int bj = 0; bj < 2; ++bj)
#pragma unroll
                    for (int n = 0; n < 2; ++n) *(f32x4*)(rowp + bj * HALF + n * 16) = acc[ai][bj][m][n]; }
    }
};
}

namespace att {
constexpr float SCALE = 0.088388347648318440f;
constexpr float THR = 8.f;
constexpr int SHM_V = 64 * 128 * 2, SHM_K = 64 * 128 * 2;
#define KSWZ(row, colB) ((row) * 256 + ((colB) ^ (((row) & 7) << 4)))
#define SBAR() __builtin_amdgcn_sched_barrier(0)
__device__ __forceinline__ int crow(int r, int hi) { return (r & 3) + 8 * (r >> 2) + 4 * hi; }
__device__ __forceinline__ void partialSM(f32x16& p0, f32x16& p1, float& m_reg, float& mn, float& alpha) {
    constexpr float C = SCALE * 1.4426950408889634f;
    float pmax = p0[0];
#pragma unroll
    for (int r = 1; r < 16; ++r) pmax = fmaxf(pmax, p0[r]);
#pragma unroll
    for (int r = 0; r < 16; ++r) pmax = fmaxf(pmax, p1[r]);
    { auto rr = __builtin_amdgcn_permlane32_swap(__float_as_uint(pmax), __float_as_uint(pmax), false, false);
      pmax = fmaxf(__uint_as_float(rr[0]), __uint_as_float(rr[1])); }
    if (__builtin_expect(__all(pmax - m_reg <= THR / SCALE), 1)) { mn = m_reg; alpha = 1.f; }
    else { mn = fmaxf(m_reg, pmax); alpha = __builtin_amdgcn_exp2f((m_reg - mn) * C); m_reg = mn; }
    const float mnC = -mn * C;
#pragma unroll
    for (int r = 0; r < 16; ++r) p0[r] = fmaf(p0[r], C, mnC);
#pragma unroll
    for (int r = 0; r < 16; ++r) p1[r] = fmaf(p1[r], C, mnC);
#pragma unroll
    for (int r = 0; r < 16; ++r) p0[r] = __builtin_amdgcn_exp2f(p0[r]);
}
__device__ __forceinline__ void finishSM(f32x16& p0, f32x16& p1, float alpha, float& l_reg, bf16x8& pa0, bf16x8& pa1, bf16x8& pa2, bf16x8& pa3) {
#pragma unroll
    for (int r = 0; r < 16; ++r) p1[r] = __builtin_amdgcn_exp2f(p1[r]);
    float ps = 0;
#pragma unroll
    for (int r = 0; r < 16; ++r) ps += p0[r];
#pragma unroll
    for (int r = 0; r < 16; ++r) ps += p1[r];
    { auto rr = __builtin_amdgcn_permlane32_swap(__float_as_uint(ps), __float_as_uint(ps), false, false);
      ps = __uint_as_float(rr[0]) + __uint_as_float(rr[1]); }
    l_reg = l_reg * alpha + ps;
#define PK4(P, BASE, OUT) do { unsigned a0 = cvt_pk_bf16(P[BASE + 0], P[BASE + 1]), a1 = cvt_pk_bf16(P[BASE + 2], P[BASE + 3]);   \
    unsigned b0 = cvt_pk_bf16(P[BASE + 4], P[BASE + 5]), b1 = cvt_pk_bf16(P[BASE + 6], P[BASE + 7]);                              \
    auto r0 = __builtin_amdgcn_permlane32_swap(a0, b0, false, false); auto r1 = __builtin_amdgcn_permlane32_swap(a1, b1, false, false); \
    u32x4 w = {r0[0], r1[0], r0[1], r1[1]}; OUT = *reinterpret_cast<bf16x8*>(&w); } while (0)
    PK4(p0, 0, pa0); PK4(p0, 8, pa1); PK4(p1, 0, pa2); PK4(p1, 8, pa3);
#undef PK4
}
__device__ __forceinline__ void qkt(f32x16& p0, f32x16& p1, const char* Ks, const bf16x8* qr, int r32, int hi) {
    p0 = f32x16{}; p1 = f32x16{};
#pragma unroll
    for (int d0 = 0; d0 < 8; ++d0) { const int cb = (d0 * 16 + hi * 8) * 2;
        const bf16x8 b0 = *reinterpret_cast<const bf16x8*>(Ks + KSWZ(r32, cb));
        const bf16x8 b1 = *reinterpret_cast<const bf16x8*>(Ks + KSWZ(32 + r32, cb));
        p0 = __builtin_amdgcn_mfma_f32_32x32x16_bf16(b0, qr[d0], p0, 0, 0, 0);
        p1 = __builtin_amdgcn_mfma_f32_32x32x16_bf16(b1, qr[d0], p1, 0, 0, 0); }
}
__device__ __forceinline__ int v_st(int k, int c) { const int kk = (k & ~0xC) | ((k & 4) << 1) | ((k & 8) >> 1); return ((kk >> 3) * 4 + (c >> 5)) * 512 + ((kk & 7) * 32 + (c & 31)) * 2; }
__device__ __forceinline__ int v_rd_base(int lane) { return ((lane & 3) << 3) | (((lane >> 2) & 3) << 6) | (((lane >> 4) & 1) << 5) | (((lane >> 5) & 1) << 8); }
constexpr int v_rd_off(int d0, int ks, int half) { return d0 * 512 + ks * 4096 + half * 2048; }
template <int OFF> __device__ __forceinline__ s16x4 tr_read(int vb) {
    s16x4 r; asm volatile("ds_read_b64_tr_b16 %0, %1 offset:%2" : "=&v"(r) : "v"(vb), "i"(OFF) : "memory"); return r;
}
template <int D0> __device__ __forceinline__ void pv_one(f32x16& od, int vb, bf16x8 pa0, bf16x8 pa1, bf16x8 pa2, bf16x8 pa3) {
    const s16x4 l0 = tr_read<v_rd_off(D0, 0, 0)>(vb), h0 = tr_read<v_rd_off(D0, 0, 1)>(vb), l1 = tr_read<v_rd_off(D0, 1, 0)>(vb), h1 = tr_read<v_rd_off(D0, 1, 1)>(vb);
    const s16x4 l2 = tr_read<v_rd_off(D0, 2, 0)>(vb), h2 = tr_read<v_rd_off(D0, 2, 1)>(vb), l3 = tr_read<v_rd_off(D0, 3, 0)>(vb), h3 = tr_read<v_rd_off(D0, 3, 1)>(vb);
    asm volatile("s_waitcnt lgkmcnt(0)" ::: "memory"); SBAR();
#define PK(L, H) (bf16x8){L[0], L[1], L[2], L[3], H[0], H[1], H[2], H[3]}
    od = __builtin_amdgcn_mfma_f32_32x32x16_bf16(pa0, PK(l0, h0), od, 0, 0, 0);
    od = __builtin_amdgcn_mfma_f32_32x32x16_bf16(pa1, PK(l1, h1), od, 0, 0, 0);
    od = __builtin_amdgcn_mfma_f32_32x32x16_bf16(pa2, PK(l2, h2), od, 0, 0, 0);
    od = __builtin_amdgcn_mfma_f32_32x32x16_bf16(pa3, PK(l3, h3), od, 0, 0, 0);
#undef PK
}

__device__ __forceinline__ void attn_unit(char* lds, const int tid, const bf16_t* Qb, bf16_t* Ob, const bf16_t* KVb, int qrow0, int t0, int b, int kvh, const float* sink_l) {
    const int wid = tid >> 6, lane = tid & 63, r32 = lane & 31, hi = lane >> 5;
    char* V_lds = lds; char* K_lds = lds + 2 * SHM_V;
    float* ws = (float*)(lds + 2 * SHM_V + 2 * SHM_K) + wid * 64; float* li_l = ws; float* al_l = ws + 32;
    const int h = kvh * 4 + (wid >> 1);
    const int qoff = (wid & 1) * 32;
    bf16x8 qr[8];
    { const bf16_t* Qw = Qb + (size_t)(qrow0 + qoff + r32) * 1024 + h * 128 + hi * 8;
#pragma unroll
      for (int d0 = 0; d0 < 8; ++d0) qr[d0] = *reinterpret_cast<const bf16x8*>(Qw + d0 * 16); }
    float m_reg = sink_l[h] / SCALE, l_reg = 1.f;
    f32x16 o[4] = {};
    int ks_first = 0, nbt = 0;
    if (t0 >= 0) { ks_first = t0 - 128 < 0 ? 0 : t0 - 128; const int ke = t0 + 192 > SEQ ? SEQ : t0 + 192; nbt = (ke - ks_first) >> 6; }
    const int NT = nbt + 4;
    const int sr = tid >> 4, sc = (tid & 15) * 8, vst0 = v_st(sr, sc), vst1 = v_st(32 + sr, sc);
    const int vb0 = (int)(uintptr_t)V_lds + v_rd_base(lane);
    bf16x8 vs0, vs1, ks0, ks1;
#define TROW(j) ((j) < nbt ? b * SEQ + ks_first + 64 * (j) : ML + b * CTX + 64 * ((j) - nbt))
#define SLOAD(j) do { const bf16_t* kp = KVb + (size_t)(TROW(j) + sr) * 512 + kvh * 128 + sc; \
    ks0 = *reinterpret_cast<const bf16x8*>(kp); ks1 = *reinterpret_cast<const bf16x8*>(kp + 32 * 512); \
    vs0 = *reinterpret_cast<const bf16x8*>(kp + 256); vs1 = *reinterpret_cast<const bf16x8*>(kp + 256 + 32 * 512); } while (0)
#define SWRITE(bu) do { *(bf16x8*)(V_lds + (bu) * SHM_V + vst0) = vs0; *(bf16x8*)(V_lds + (bu) * SHM_V + vst1) = vs1; const int kc = sc * 2; \
    *(bf16x8*)(K_lds + (bu) * SHM_K + KSWZ(sr, kc)) = ks0; *(bf16x8*)(K_lds + (bu) * SHM_K + KSWZ(32 + sr, kc)) = ks1; } while (0)
    SLOAD(0); SWRITE(0); __syncthreads();
    const int qpos = t0 + qoff + r32;
    for (int j = 0; j < NT; ++j) {
        const int bu = j & 1;
        f32x16 p0, p1; float mn, alpha; bf16x8 pa0, pa1, pa2, pa3;
        qkt(p0, p1, K_lds + bu * SHM_K, qr, r32, hi);
        const int kw = ks_first + 64 * j - (t0 + qoff);
        if (j < nbt && (kw + 63 > 128 || kw < -97)) { const int kb = ks_first + 64 * j - qpos;
#pragma unroll
            for (int r = 0; r < 16; ++r) { const int d0 = kb + crow(r, hi), d1 = d0 + 32;
                if (d0 > 128 || d0 < -128) p0[r] = -1e30f; if (d1 > 128 || d1 < -128) p1[r] = -1e30f; } }
        partialSM(p0, p1, m_reg, mn, alpha);
        if (__any(alpha < 1.f)) { if (hi == 0) al_l[r32] = alpha; asm volatile("s_waitcnt lgkmcnt(0)" ::: "memory");
#pragma unroll
            for (int d = 0; d < 4; ++d)
#pragma unroll
                for (int r = 0; r < 16; ++r) o[d][r] *= al_l[crow(r, hi)]; }
        finishSM(p0, p1, alpha, l_reg, pa0, pa1, pa2, pa3); SBAR();
        if (j + 1 < NT) SLOAD(j + 1);
        SBAR();
        const int vb = vb0 + bu * SHM_V;
        pv_one<0>(o[0], vb, pa0, pa1, pa2, pa3); pv_one<1>(o[1], vb, pa0, pa1, pa2, pa3); pv_one<2>(o[2], vb, pa0, pa1, pa2, pa3); pv_one<3>(o[3], vb, pa0, pa1, pa2, pa3);
        if (j + 1 < NT) SWRITE(bu ^ 1);
        __syncthreads();
    }
    if (hi == 0) li_l[r32] = l_reg; asm volatile("s_waitcnt lgkmcnt(0)" ::: "memory");
    bf16_t* Ow = Ob + (size_t)(qrow0 + qoff) * 1024 + h * 128;
#pragma unroll
    for (int r = 0; r < 16; ++r) { const int orow = crow(r, hi); const float rl = __builtin_amdgcn_rcpf(li_l[orow]);
#pragma unroll
        for (int d0 = 0; d0 < 4; ++d0) { const unsigned w = cvt_pk_bf16(o[d0][r] * rl, 0.f); Ow[(size_t)orow * 1024 + d0 * 32 + r32] = (bf16_t)(w & 0xffffu); } }
#undef TROW
#undef SLOAD
#undef SWRITE
}
}

#define XB_TMO      128
#define XB_XCNT(j)  (256  + 64 * (j))
#define XB_XSUB(j)  (1280 + 64 * (j))
#define XB_XGEN(j)  (2304 + 64 * (j))
#define XB_TOP      3328
#define XB_TOPGEN   3392
#define XCD_BAR_WORDS 3456
#define XB_SPIN_CAP (1u << 18)
__device__ __forceinline__ unsigned xb_ld(unsigned* p)              { return __hip_atomic_load(p, __ATOMIC_RELAXED, __HIP_MEMORY_SCOPE_AGENT); }
__device__ __forceinline__ unsigned xb_add(unsigned* p, unsigned v) { return __hip_atomic_fetch_add(p, v, __ATOMIC_RELAXED, __HIP_MEMORY_SCOPE_AGENT); }
__device__ __forceinline__ unsigned xb_xcc_id() { return (unsigned)__builtin_amdgcn_s_getreg((3 << 11) | 20) & 0xFu; }
#define XB_SPIN(cond, bar) do { unsigned _sp = 0; while (cond) { __builtin_amdgcn_s_sleep(1); \
    if ((++_sp & 255u) == 0u) { if (xb_ld(&(bar)[XB_TMO])) break; if (_sp > XB_SPIN_CAP) { atomicAdd(&(bar)[XB_TMO], 1u); break; } } } } while (0)
struct XcdBarrier { unsigned* bar; unsigned x; volatile LAS unsigned* st; };
__device__ __forceinline__ XcdBarrier xcd_barrier_post(unsigned* bar, volatile LAS unsigned* st) {
    XcdBarrier b; b.bar = bar; b.x = xb_xcc_id(); b.st = st;
    if (threadIdx.x == 0) (void)xb_add(&bar[XB_XCNT(b.x)], 1u);
    return b;
}
__device__ __forceinline__ void xcd_barrier_complete(unsigned* bar, unsigned x, unsigned& nloc, unsigned& nx) {
    const unsigned G = gridDim.x * gridDim.y * gridDim.z;
    unsigned sum, cnt, mine, sp = 0u;
    for (;;) {
        sum = 0u; cnt = 0u; mine = 0u;
#pragma unroll
        for (unsigned j = 0; j < 16; ++j) { const unsigned c = xb_ld(&bar[XB_XCNT(j)]); sum += c; cnt += (c > 0u) ? 1u : 0u; mine = (j == x) ? c : mine; }
        if (sum == G) break;
        __builtin_amdgcn_s_sleep(1);
        if ((++sp & 255u) == 0u) { if (xb_ld(&bar[XB_TMO])) break; if (sp > XB_SPIN_CAP) { atomicAdd(&bar[XB_TMO], 1u); break; } }
    }
    nloc = mine > 0u ? mine : 1u; nx = cnt > 0u ? cnt : 1u;
}
__device__ __forceinline__ void xcd_barrier(const XcdBarrier& b) {
    asm volatile("s_waitcnt vmcnt(0)" ::: "memory");
    __syncthreads();
    if (threadIdx.x == 0) {
        unsigned* bar = b.bar;
        __builtin_amdgcn_s_waitcnt(0);
        unsigned nloc = b.st[0], nx = b.st[1];
        if (nloc == 0u) { xcd_barrier_complete(bar, b.x, nloc, nx); b.st[0] = nloc; b.st[1] = nx; }
        const unsigned old = xb_add(&bar[XB_XSUB(b.x)], 1u);
        const unsigned gen = old / nloc;
        if (old + 1u == (gen + 1u) * nloc) {
            __builtin_amdgcn_fence(__ATOMIC_RELEASE, "agent");
            asm volatile("s_waitcnt vmcnt(0)" ::: "memory");
            const unsigned og = xb_add(&bar[XB_TOP], 1u);
            const unsigned tg = og / nx;
            if (og + 1u == (tg + 1u) * nx) xb_add(&bar[XB_TOPGEN], 1u);
            else XB_SPIN(xb_ld(&bar[XB_TOPGEN]) == tg, bar);
            __builtin_amdgcn_fence(__ATOMIC_ACQUIRE, "agent");
            xb_add(&bar[XB_XGEN(b.x)], 1u);
            asm volatile("s_waitcnt vmcnt(0)" ::: "memory");
        } else {
            XB_SPIN(xb_ld(&bar[XB_XGEN(b.x)]) == gen, bar);
            __builtin_amdgcn_fence(__ATOMIC_ACQUIRE, "agent");
            asm volatile("s_waitcnt vmcnt(0)" ::: "memory");
        }
    }
    __syncthreads();
}

struct Params { const float* in[24]; float* out; unsigned char* ws; int ph_lo, ph_hi; };

struct Ctx {
    const Params* p; LAS unsigned char* lds; char* ldsg; int tid, lane, wave, G, bid;
};

__device__ __forceinline__ int rope_perm_col(int c) {
    const int d = c & 63, n = d >> 5, f = d & 31; return (c & ~63) + 32 * (f >> 4) + 8 * ((f >> 2) & 3) + 4 * n + (f & 3);
}
struct TItem { const float* W; bf16_t* WT; int ldw, ldt, k0, n0, drow0, rperm; float scale; };
__device__ __forceinline__ void titem_load(const TItem& t, float (&tv)[32], int lane) {
#pragma unroll
    for (int i = 0; i < 32; ++i) tv[i] = t.scale * t.W[(size_t)(t.k0 + i) * t.ldw + t.n0 + lane];
}
__device__ __forceinline__ void titem_store(const TItem& t, const float (&tv)[32], LAS float* scr, int lane) {
#pragma unroll
    for (int i = 0; i < 32; ++i) scr[i * 65 + lane] = tv[i];
    asm volatile("s_waitcnt lgkmcnt(0)" ::: "memory");
    const int c = lane & 3;
#pragma unroll
    for (int j = 0; j < 4; ++j) { const int n = (lane >> 2) + 16 * j; const LAS float* s = scr + (8 * c) * 65 + n;
        u32x4 o; o.x = cvt_pk_bf16(s[0 * 65], s[1 * 65]); o.y = cvt_pk_bf16(s[2 * 65], s[3 * 65]); o.z = cvt_pk_bf16(s[4 * 65], s[5 * 65]); o.w = cvt_pk_bf16(s[6 * 65], s[7 * 65]);
        const int drow = t.rperm ? rope_perm_col(t.drow0 + n) : t.drow0 + n;
        *(u32x4*)(t.WT + (size_t)drow * t.ldt + t.k0 + 8 * c) = o; }
    asm volatile("s_waitcnt lgkmcnt(0)" ::: "memory");
}
constexpr int WA_ITEMS = 32 * 88 + 3 * 32 * 16 + 256;
__device__ __forceinline__ TItem decode_WA(const Params& P, int l, int it) {
    unsigned char* W = P.ws + OFF_W; TItem t; constexpr int I_IN = 32 * 88, I_SQ = 32 * 16;
    int r = it; t.scale = 1.0f;
    if (r < I_IN) { const int kb = r / 88, nb = r % 88; t.W = P.in[10] + (size_t)l * 1024 * INW; t.ldw = INW; t.k0 = kb * 32; t.n0 = nb * 64; t.WT = (bf16_t*)(W + W_WIN); t.ldt = 1024; t.drow0 = nb * 64; t.rperm = (nb >= 32 && nb < 52) ? 1 : 0; return t; }
    r -= I_IN;
    if (r < 3 * I_SQ) { const int which = r / I_SQ; r %= I_SQ; const int kb = r / 16, nb = r % 16; t.W = P.in[19 + which] + (size_t)l * 1024 * 1024; t.ldw = 1024; t.k0 = kb * 32; t.n0 = nb * 64;
        t.WT = (bf16_t*)(W + (which == 0 ? W_WOR : which == 1 ? W_WOA : W_WOUT)); t.ldt = 1024; t.drow0 = nb * 64; t.rperm = 0; return t; }
    r -= 3 * I_SQ;
    { const int mat = r >> 3, sub = r & 7, kb = sub >> 1, nb = sub & 1; const int dir = mat >> 4, g = (mat >> 3) & 1, blk = mat & 7;
      t.W = P.in[g ? 15 : 13] + ((size_t)(l * 2 + dir) * 8 + blk) * 128 * 128; t.ldw = 128; t.k0 = kb * 32; t.n0 = nb * 64; t.WT = (bf16_t*)(W + W_WG) + (size_t)mat * 128 * 128; t.ldt = 128; t.drow0 = nb * 64; t.rperm = 0; t.scale = -1.4426950408889634f; return t; }
}
constexpr int WF_ITEMS = 32 * 88 + 88 * 16;
__device__ __forceinline__ TItem decode_WF(const Params& P, int l, int it) {
    unsigned char* W = P.ws + OFF_W; TItem t; constexpr int I_FI = 32 * 88;
    int r = it; t.rperm = 0; t.scale = 1.0f;
    if (r < I_FI) { const int kb = r / 88, nb = r % 88; const int n0 = nb * 64; const int up = n0 >= DFF ? 1 : 0, nn = n0 - up * DFF;
        t.W = P.in[22] + (size_t)l * 1024 * INW; t.ldw = INW; t.k0 = kb * 32; t.n0 = n0; t.WT = (bf16_t*)(W + W_WFI); t.ldt = 1024; t.drow0 = 256 * (nn >> 7) + 128 * up + (nn & 127); return t; }
    r -= I_FI;
    { const int kb = r / 16, nb = r % 16; t.W = P.in[23] + (size_t)l * DFF * 1024; t.ldw = 1024; t.k0 = kb * 32; t.n0 = nb * 64; t.WT = (bf16_t*)(W + W_WFO); t.ldt = DFF; t.drow0 = nb * 64; return t; }
}
template <bool FFN>
__device__ __forceinline__ void convert_weights(const Ctx& F, int l) {
    const Params& P = *F.p;
    LAS float* scr = (LAS float*)(F.lds + F.wave * 16384);
    const int gw = F.bid * 8 + F.wave, NGW = F.G * 8; constexpr int NIT = FFN ? WF_ITEMS : WA_ITEMS;
    if (gw >= NIT) return;
    float tva[32], tvb[32];
    TItem ca = FFN ? decode_WF(P, l, gw) : decode_WA(P, l, gw), cb = ca;
    titem_load(ca, tva, F.lane);
    for (int it = gw; it < NIT; it += 2 * NGW) {
        const bool hb = it + NGW < NIT;
        if (hb) { cb = FFN ? decode_WF(P, l, it + NGW) : decode_WA(P, l, it + NGW); titem_load(cb, tvb, F.lane); }
        titem_store(ca, tva, scr, F.lane);
        if (!hb) break;
        const bool ha = it + 2 * NGW < NIT;
        if (ha) { ca = FFN ? decode_WF(P, l, it + 2 * NGW) : decode_WA(P, l, it + 2 * NGW); titem_load(ca, tva, F.lane); }
        titem_store(cb, tvb, scr, F.lane);
        if (!ha) break;
    }
}
__device__ __forceinline__ void convert_WA(const Ctx& F, int l) { convert_weights<false>(F, l); }
__device__ __forceinline__ void convert_WF(const Ctx& F, int l) { convert_weights<true>(F, l); }

__device__ __forceinline__ void mod_phase(const Ctx& F) {
    const Params& P = *F.p; float* MOD = (float*)(P.ws + OFF_MOD);
    LAS float* sv = (LAS float*)F.lds;
    LAS float* red = (LAS float*)(F.lds + 32768);
    if (F.bid >= 192) return;
    for (int i = F.tid; i < 1024; i += 512) {
#pragma unroll
        for (int r = 0; r < 4; ++r) sv[i * 8 + r] = siluf_(P.in[1][r * 1024 + i]);
        sv[i * 8 + 4] = siluf_(P.in[3][i]); sv[i * 8 + 5] = 0.f; sv[i * 8 + 6] = 0.f; sv[i * 8 + 7] = 0.f; }
    __syncthreads();
    for (int it = F.bid; it < 192; it += F.G) {
        const int l = it / 96, n0 = (it % 96) * 64;
        const float* Wm = P.in[4] + (size_t)l * 1024 * 6144 + n0 + F.lane;
        float a0 = 0, a1 = 0, a2 = 0, a3 = 0, a4 = 0;
        const int kb = F.wave * 128;
#pragma unroll 32
        for (int k = 0; k < 128; ++k) { const float w = Wm[(size_t)(kb + k) * 6144]; const LAS float* s = sv + (kb + k) * 8;
            const f32x4 s4 = *(const LAS f32x4*)s; a0 += s4[0] * w; a1 += s4[1] * w; a2 += s4[2] * w; a3 += s4[3] * w; a4 += s[4] * w; }
        red[(F.wave * 5 + 0) * 64 + F.lane] = a0; red[(F.wave * 5 + 1) * 64 + F.lane] = a1; red[(F.wave * 5 + 2) * 64 + F.lane] = a2;
        red[(F.wave * 5 + 3) * 64 + F.lane] = a3; red[(F.wave * 5 + 4) * 64 + F.lane] = a4;
        __syncthreads();
        if (F.wave < 5) { float s = 0;
#pragma unroll
            for (int w = 0; w < 8; ++w) s += red[(w * 5 + F.wave) * 64 + F.lane];
            MOD[(size_t)(l * 5 + F.wave) * 6144 + n0 + F.lane] = s + P.in[5][l * 6144 + n0 + F.lane]; }
        __syncthreads();
    }
}

template <bool BR, bool WH>
__device__ __forceinline__ void norm_phase(const Ctx& F, int nrows, const float* xin_lat, const float* xin_ctx, const bf16_t* branch, const bf16_t* slabs, const float* g_post, const float* mod_g, int gate_off,
                                           float* xout_lat, float* xout_ctx, const float* g_pre, const float* mod_h, int sc_off, int sh_off, bf16_t* Hout) {
    const int gw = F.bid * 8 + F.wave, NGW = F.G * 8, lane = F.lane;
    f32x4 xc[4], xn[4]; u32x2 bc[4], bn[4];
#define NORM_LOAD(row_, X_, B_) do { const int r__ = (row_); const float* xr = r__ < ML ? xin_lat + (size_t)r__ * 1024 : xin_ctx + (size_t)(r__ - ML) * 1024; \
        _Pragma("unroll") for (int j = 0; j < 4; ++j) X_[j] = *(const f32x4*)(xr + 4 * lane + 256 * j); \
        if (BR) { if (slabs != nullptr && r__ >= ML) { _Pragma("unroll") for (int j = 0; j < 4; ++j) { f32x4 a = {0.f, 0.f, 0.f, 0.f}; \
                      _Pragma("unroll") for (int sl = 0; sl < 4; ++sl) { const u32x2 bw = *(const u32x2*)(slabs + (size_t)sl * (1024 * 1024) + (size_t)(r__ - ML) * 1024 + 4 * lane + 256 * j); a = a + (f32x4){bflo(bw.x), bfhi(bw.x), bflo(bw.y), bfhi(bw.y)}; } \
                      B_[j].x = cvt_pk_bf16(a[0], a[1]); B_[j].y = cvt_pk_bf16(a[2], a[3]); } } \
                  else { _Pragma("unroll") for (int j = 0; j < 4; ++j) B_[j] = *(const u32x2*)(branch + (size_t)r__ * 1024 + 4 * lane + 256 * j); } } } while (0)
    if (gw >= nrows) return;
    NORM_LOAD(gw, xc, bc);
    for (int row = gw; row < nrows; row += NGW) {
        const bool hn = row + NGW < nrows;
        if (hn) NORM_LOAD(row + NGW, xn, bn);
        const int mrow = row < ML ? (row >> 12) : 4;
        f32x4 x[4];
#pragma unroll
        for (int j = 0; j < 4; ++j) x[j] = xc[j];
        if (BR) {
            f32x4 m[4]; float s = 0.f;
#pragma unroll
            for (int j = 0; j < 4; ++j) { m[j] = (f32x4){bflo(bc[j].x), bfhi(bc[j].x), bflo(bc[j].y), bfhi(bc[j].y)};
                s += (m[j][0] * m[j][0] + m[j][1] * m[j][1]) + (m[j][2] * m[j][2] + m[j][3] * m[j][3]); }
            const float rs = rsqrtf(wave_sum(s, lane) * (1.f / 1024.f) + EPS);
            float* xo = row < ML ? xout_lat + (size_t)row * 1024 : xout_ctx + (size_t)(row - ML) * 1024;
#pragma unroll
            for (int j = 0; j < 4; ++j) { const f32x4 gp = *(const f32x4*)(g_post + 4 * lane + 256 * j), ga = *(const f32x4*)(mod_g + (size_t)mrow * 6144 + gate_off + 4 * lane + 256 * j);
                x[j] = x[j] + ga * ((m[j] * rs) * gp); __builtin_nontemporal_store(x[j], (f32x4*)(xo + 4 * lane + 256 * j)); }
        }
        if (WH) {
            float s = 0.f;
#pragma unroll
            for (int j = 0; j < 4; ++j) s += (x[j][0] * x[j][0] + x[j][1] * x[j][1]) + (x[j][2] * x[j][2] + x[j][3] * x[j][3]);
            const float rs = rsqrtf(wave_sum(s, lane) * (1.f / 1024.f) + EPS);
#pragma unroll
            for (int j = 0; j < 4; ++j) { const f32x4 gp = *(const f32x4*)(g_pre + 4 * lane + 256 * j), sc = *(const f32x4*)(mod_h + (size_t)mrow * 6144 + sc_off + 4 * lane + 256 * j),
                    sh = *(const f32x4*)(mod_h + (size_t)mrow * 6144 + sh_off + 4 * lane + 256 * j);
                const f32x4 hv = ((x[j] * rs) * gp) * (sc + 1.0f) + sh;
                u32x2 w; w.x = cvt_pk_bf16(hv[0], hv[1]); w.y = cvt_pk_bf16(hv[2], hv[3]);
                *(u32x2*)(Hout + (size_t)row * 1024 + 4 * lane + 256 * j) = w; }
        }
        if (!hn) break;
#pragma unroll
        for (int j = 0; j < 4; ++j) { xc[j] = xn[j]; bc[j] = bn[j]; }
    }
#undef NORM_LOAD
}

__device__ __forceinline__ void rope_phase(const Ctx& F, bf16_t* Qb, bf16_t* KVb) {
    const int gw = F.bid * 8 + F.wave, NGW = F.G * 8, lane = F.lane;
    const int axis = lane >> 5, f = lane & 31;
    const float inv = exp2f(-(float)f * (13.287712379549449f / 32.0f));
    for (int row = gw; row < ML; row += NGW) {
        const int t = row & (SEQ - 1); const int pos = axis ? (t & 63) : (t >> 6);
        float sn, cs; sincosf((float)pos * inv, &sn, &cs);
        bf16_t* q = Qb + (size_t)row * 1024 + axis * 64 + f;
#pragma unroll
        for (int h = 0; h < 8; ++h) { const float x1 = bf2f(q[h * 128]), x2 = bf2f(q[h * 128 + 32]);
            const unsigned w = cvt_pk_bf16(x1 * cs - x2 * sn, x2 * cs + x1 * sn); q[h * 128] = (bf16_t)(w & 0xffff); q[h * 128 + 32] = (bf16_t)(w >> 16); }
        bf16_t* k = KVb + (size_t)row * 512 + axis * 64 + f;
#pragma unroll
        for (int h = 0; h < 2; ++h) { const float x1 = bf2f(k[h * 128]), x2 = bf2f(k[h * 128 + 32]);
            const unsigned w = cvt_pk_bf16(x1 * cs - x2 * sn, x2 * cs + x1 * sn); k[h * 128] = (bf16_t)(w & 0xffff); k[h * 128 + 32] = (bf16_t)(w >> 16); }
    }
}

constexpr int XT_LD = 136;
constexpr int RG_XT_BYTES = 64 * XT_LD * 2;
constexpr int RG_CW_OFF = RG_XT_BYTES, RG_CW_BYTES = 3072;
constexpr int RG_SC_OFF = RG_CW_OFF + RG_CW_BYTES;
constexpr int RG_SC_BYTES = 16640 + 1152;
template <int PASS>
__device__ __forceinline__ void rglru_phase(const Ctx& F, int l, const bf16_t* XRb, bf16_t* GRb, bool latent_only = false) {
    const Params& P = *F.p;
    const int tid = F.tid, lane = F.lane, wave = F.wave;
    LAS bf16_t* XT = (LAS bf16_t*)F.lds;
    LAS float* CW = (LAS float*)(F.lds + RG_CW_OFF);
    LAS float* SCF = (LAS float*)(F.lds + RG_SC_OFF + wave * RG_SC_BYTES);
    LAS f32x2* AB = (LAS f32x2*)SCF;
    LAS float* CAR = (LAS float*)(F.lds + RG_SC_OFF + wave * RG_SC_BYTES + 16640);
    f32x2* AGG = (f32x2*)(P.ws + OFF_AGG);
    const bf16_t* WgT = (const bf16_t*)(P.ws + OFF_W + W_WG);
    const float* convw = P.in[11] + (size_t)l * 4 * 1024; const float* convb = P.in[12] + (size_t)l * 1024;
    const int cw = wave * 16, l15 = lane & 15, l4 = lane >> 4;
    const int tt = tid >> 3, cs = (tid & 7) * 16;
    for (int su = F.bid; su < 256; su += F.G) {
        const int pair = su >> 3, rg = su & 7, b = pair >> 3, blk = pair & 7;
        const int c0 = latent_only ? 4 + 8 * rg : (rg < 4 ? 9 * rg : 36 + 8 * (rg - 4)), c1 = latent_only ? 12 + 8 * rg : (rg < 3 ? 9 * (rg + 1) : 36 + 8 * (rg - 3));
        __syncthreads();
        for (int i = tid; i < 640; i += 512) CW[i] = i < 512 ? convw[(i >> 7) * 1024 + blk * 128 + (i & 127)] : convb[blk * 128 + (i - 512)];
        bf16x8 Bf[4][4];
#pragma unroll
        for (int gt = 0; gt < 4; ++gt)
#pragma unroll
            for (int ks = 0; ks < 4; ++ks) Bf[gt][ks] = *(const bf16x8*)(WgT + ((size_t)(gt * 8 + blk) * 128 + cw + l15) * 128 + ks * 32 + 8 * l4);
        const int ch = blk * 128 + cw + l15;
        float nba[2], nbx[2], cl2[2];
#pragma unroll
        for (int d = 0; d < 2; ++d) { nba[d] = -1.4426950408889634f * P.in[14][(l * 2 + d) * 1024 + ch]; nbx[d] = -1.4426950408889634f * P.in[16][(l * 2 + d) * 1024 + ch];
            cl2[d] = -8.0f * 1.4426950408889634f * log1pf(__expf(-P.in[17][(l * 2 + d) * 1024 + ch])); }
        if (PASS == 2) {
#pragma unroll 1
            for (int d = 0; d < 2; ++d) {
                __builtin_amdgcn_wave_barrier();
                for (int k = l4; k < NCH; k += 4) AB[k * 16 + l15] = AGG[((size_t)(b * 2 + d) * NCH + k) * 1024 + ch];
                asm volatile("s_waitcnt vmcnt(0) lgkmcnt(0)" ::: "memory"); __builtin_amdgcn_wave_barrier();
                if (lane < 16) { float h = 0.f;
#pragma unroll 4
                    for (int q = 0; q < NCH; ++q) { const int c = d ? (q < 4 ? 3 - q : 71 - q) : q;
                        if (c >= c0 && c < c1) CAR[(d * 9 + (c - c0)) * 16 + lane] = h;
                        const f32x2 ag = AB[c * 16 + lane]; h = ag[0] * h + ag[1]; } }
                asm volatile("s_waitcnt lgkmcnt(0)" ::: "memory"); __builtin_amdgcn_wave_barrier();
            }
        }
        u32x4 xin[4][2];
#define RG_LOADX(c_) do { const int c__ = (c_); const int sr0 = c__ < 4 ? ML + b * CTX : b * SEQ, sl = c__ < 4 ? CTX : SEQ, t0_ = c__ < 4 ? 64 * c__ : 64 * (c__ - 4); \
        _Pragma("unroll") for (int k = 0; k < 4; ++k) { const int tl = t0_ + tt + k - 2; \
            if (tl >= 0 && tl < sl) { const bf16_t* xp = XRb + (size_t)(sr0 + tl) * 1024 + blk * 128 + cs; xin[k][0] = *(const u32x4*)xp; xin[k][1] = *(const u32x4*)(xp + 8); } \
            else { xin[k][0] = (u32x4){0u, 0u, 0u, 0u}; xin[k][1] = (u32x4){0u, 0u, 0u, 0u}; } } } while (0)
        RG_LOADX(c0);
        for (int c = c0; c < c1; ++c) {
            const int seg_row0 = c < 4 ? ML + b * CTX : b * SEQ, tl0 = c < 4 ? 64 * c : 64 * (c - 4);
            __syncthreads();
            {
                float y[16];
#pragma unroll
                for (int e = 0; e < 4; ++e) { const f32x4 bv = *(const LAS f32x4*)(CW + 512 + cs + 4 * e); y[4 * e] = bv[0]; y[4 * e + 1] = bv[1]; y[4 * e + 2] = bv[2]; y[4 * e + 3] = bv[3]; }
#pragma unroll
                for (int k = 0; k < 4; ++k)
#pragma unroll
                    for (int e = 0; e < 4; ++e) { const f32x4 wv = *(const LAS f32x4*)(CW + k * 128 + cs + 4 * e); const unsigned w0 = xin[k][e >> 1][2 * (e & 1)], w1 = xin[k][e >> 1][2 * (e & 1) + 1];
                        y[4 * e] += bflo(w0) * wv[0]; y[4 * e + 1] += bfhi(w0) * wv[1]; y[4 * e + 2] += bflo(w1) * wv[2]; y[4 * e + 3] += bfhi(w1) * wv[3]; }
                u32x4 o0, o1; o0.x = cvt_pk_bf16(y[0], y[1]); o0.y = cvt_pk_bf16(y[2], y[3]); o0.z = cvt_pk_bf16(y[4], y[5]); o0.w = cvt_pk_bf16(y[6], y[7]);
                o1.x = cvt_pk_bf16(y[8], y[9]); o1.y = cvt_pk_bf16(y[10], y[11]); o1.z = cvt_pk_bf16(y[12], y[13]); o1.w = cvt_pk_bf16(y[14], y[15]);
                *(LAS u32x4*)(XT + tt * XT_LD + cs) = o0; *(LAS u32x4*)(XT + tt * XT_LD + cs + 8) = o1;
            }
            __syncthreads();
            if (c + 1 < c1) RG_LOADX(c + 1);
            u32x4 g0, g1;
            if (PASS == 2) { const bf16_t* gp = GRb + (size_t)(seg_row0 + tl0 + lane) * 1024 + blk * 128 + cw; g0 = *(const u32x4*)gp; g1 = *(const u32x4*)(gp + 8); }
            float aggA[2] = {1.f, 1.f}, aggB[2] = {0.f, 0.f};
            float hF = PASS == 2 ? CAR[(0 * 9 + (c - c0)) * 16 + l15] : 0.f;
            float hfv[4][4], ba_[4][4], bb_[4][4], bAe[4], bBe[4], bAt[4], bBt[4];
#pragma unroll
            for (int mt = 0; mt < 4; ++mt) {
                f32x4 ag[4];
#pragma unroll
                for (int gt = 0; gt < 4; ++gt) { const float nb = (gt & 1) ? nbx[gt >> 1] : nba[gt >> 1]; ag[gt] = (f32x4){nb, nb, nb, nb}; }
#pragma unroll
                for (int ks = 0; ks < 4; ++ks) { const bf16x8 af = *(const LAS bf16x8*)(XT + (mt * 16 + l15) * XT_LD + ks * 32 + 8 * l4);
#pragma unroll
                    for (int gt = 0; gt < 4; ++gt) ag[gt] = __builtin_amdgcn_mfma_f32_16x16x32_bf16(af, Bf[gt][ks], ag[gt], 0, 0, 0); }
                float ea[2][4], eb[2][4];
#pragma unroll
                for (int r = 0; r < 4; ++r) { const int tok = mt * 16 + 4 * l4 + r;
                    const float xv = bf2f(XT[tok * XT_LD + cw + l15]);
#pragma unroll
                    for (int d = 0; d < 2; ++d) {
                        const float e1 = 1.0f + __builtin_amdgcn_exp2f(ag[2 * d][r]), e2 = 1.0f + __builtin_amdgcn_exp2f(ag[2 * d + 1][r]);
                        const float inv = __builtin_amdgcn_rcpf(e1 * e2); const float rgate = e2 * inv, igate = e1 * inv;
                        const float a = __builtin_amdgcn_exp2f(rgate * cl2[d]);
                        const float om = fmaf(-a, a, 1.0f);
                        const float bv = __builtin_amdgcn_sqrtf(om) * (igate * xv);
                        ea[d][r] = a; eb[d][r] = bv; } }
                if (PASS == 1) {
#pragma unroll
                    for (int d = 0; d < 2; ++d) {
                        float A, B;
                        if (d == 0) { A = ea[0][0]; B = eb[0][0];
#pragma unroll
                            for (int r = 1; r < 4; ++r) { B = ea[0][r] * B + eb[0][r]; A *= ea[0][r]; } }
                        else { A = ea[1][3]; B = eb[1][3];
#pragma unroll
                            for (int r = 2; r >= 0; --r) { B = ea[1][r] * B + eb[1][r]; A *= ea[1][r]; } }
                        { const float Ap = __uint_as_float(__builtin_amdgcn_ds_bpermute((lane ^ 16) << 2, __float_as_uint(A))), Bp = __uint_as_float(__builtin_amdgcn_ds_bpermute((lane ^ 16) << 2, __float_as_uint(B)));
                          const bool mefirst = d == 0 ? ((l4 & 1) == 0) : ((l4 & 1) == 1);
                          const float nB = mefirst ? Ap * B + Bp : A * Bp + B; A = A * Ap; B = nB; }
                        { const float Ap = __uint_as_float(__builtin_amdgcn_ds_bpermute((lane ^ 32) << 2, __float_as_uint(A))), Bp = __uint_as_float(__builtin_amdgcn_ds_bpermute((lane ^ 32) << 2, __float_as_uint(B)));
                          const bool mefirst = d == 0 ? (l4 < 2) : (l4 >= 2);
                          const float nB = mefirst ? Ap * B + Bp : A * Bp + B; A = A * Ap; B = nB; }
                        if (d == 0) { aggB[0] = A * aggB[0] + B; aggA[0] *= A; }
                        else { aggB[1] = aggA[1] * B + aggB[1]; aggA[1] *= A; }
                    }
                }
                if (PASS == 2) {
#define BPF(src_, v_) __uint_as_float(__builtin_amdgcn_ds_bpermute(((src_) & 63) << 2, __float_as_uint(v_)))
                    {
                        float A = ea[0][0], B = eb[0][0];
#pragma unroll
                        for (int r = 1; r < 4; ++r) { B = ea[0][r] * B + eb[0][r]; A *= ea[0][r]; }
                        { const float Ap = BPF(lane - 16, A), Bp = BPF(lane - 16, B); if (l4 >= 1) { B = A * Bp + B; A = A * Ap; } }
                        { const float Ap = BPF(lane - 32, A), Bp = BPF(lane - 32, B); if (l4 >= 2) { B = A * Bp + B; A = A * Ap; } }
                        const float At = BPF(48 + l15, A), Bt = BPF(48 + l15, B);
                        float Ae = BPF(lane - 16, A), Be = BPF(lane - 16, B); if (l4 == 0) { Ae = 1.f; Be = 0.f; }
                        float h = Ae * hF + Be;
#pragma unroll
                        for (int r = 0; r < 4; ++r) { h = ea[0][r] * h + eb[0][r]; hfv[mt][r] = h; }
                        hF = At * hF + Bt;
                    }
                    {
                        float A = ea[1][3], B = eb[1][3];
#pragma unroll
                        for (int r = 2; r >= 0; --r) { B = ea[1][r] * B + eb[1][r]; A *= ea[1][r]; }
                        { const float Ap = BPF(lane + 16, A), Bp = BPF(lane + 16, B); if (l4 <= 2) { B = A * Bp + B; A = A * Ap; } }
                        { const float Ap = BPF(lane + 32, A), Bp = BPF(lane + 32, B); if (l4 <= 1) { B = A * Bp + B; A = A * Ap; } }
                        bAt[mt] = BPF(l15, A); bBt[mt] = BPF(l15, B);
                        float Ae = BPF(lane + 16, A), Be = BPF(lane + 16, B); if (l4 == 3) { Ae = 1.f; Be = 0.f; }
                        bAe[mt] = Ae; bBe[mt] = Be;
#pragma unroll
                        for (int r = 0; r < 4; ++r) { ba_[mt][r] = ea[1][r]; bb_[mt][r] = eb[1][r]; }
                    }
                }
            }
            if (PASS == 1) { if (lane < 16) { AGG[((size_t)(b * 2 + 0) * NCH + c) * 1024 + ch] = (f32x2){aggA[0], aggB[0]}; AGG[((size_t)(b * 2 + 1) * NCH + c) * 1024 + ch] = (f32x2){aggA[1], aggB[1]}; } }
            asm volatile("s_waitcnt lgkmcnt(0)" ::: "memory"); __builtin_amdgcn_wave_barrier();
            if (PASS == 2) {
                float hB = CAR[(1 * 9 + (c - c0)) * 16 + l15];
#pragma unroll
                for (int mt = 3; mt >= 0; --mt) { float h = bAe[mt] * hB + bBe[mt];
#pragma unroll
                    for (int r = 3; r >= 0; --r) { h = ba_[mt][r] * h + bb_[mt][r]; SCF[(r + 4 * mt + 16 * l4) * 17 + l15] = hfv[mt][r] + h; }
                    hB = bAt[mt] * hB + bBt[mt]; }
                asm volatile("s_waitcnt lgkmcnt(0)" ::: "memory"); __builtin_amdgcn_wave_barrier();
                const size_t go = (size_t)(seg_row0 + tl0 + lane) * 1024 + blk * 128 + cw;
                float u[16];
                const int pl = (lane & 3) + 4 * (lane >> 4) + 16 * ((lane >> 2) & 3);
#pragma unroll
                for (int e = 0; e < 16; ++e) { const float hs = SCF[pl * 17 + e]; const unsigned gw = e < 8 ? g0[e >> 1] : g1[(e - 8) >> 1];
                    u[e] = hs * gelu_tanh((e & 1) ? bfhi(gw) : bflo(gw)); }
                u32x4 o0, o1; o0.x = cvt_pk_bf16(u[0], u[1]); o0.y = cvt_pk_bf16(u[2], u[3]); o0.z = cvt_pk_bf16(u[4], u[5]); o0.w = cvt_pk_bf16(u[6], u[7]);
                o1.x = cvt_pk_bf16(u[8], u[9]); o1.y = cvt_pk_bf16(u[10], u[11]); o1.z = cvt_pk_bf16(u[12], u[13]); o1.w = cvt_pk_bf16(u[14], u[15]);
                *(u32x4*)(GRb + go) = o0; *(u32x4*)(GRb + go + 8) = o1;
            }
            __builtin_amdgcn_wave_barrier();
        }
#undef RG_LOADX
#undef BPF
    }
}

__device__ __forceinline__ void attn_phase(const Ctx& F, int l, const bf16_t* Qb, bf16_t* Ob, const bf16_t* KVb, bool with_ctx) {
    const Params& P = *F.p;
    const int nlat = NB * 2 * 64, nun = nlat + (with_ctx ? NB * 2 * 4 : 0);
    const float* sink = P.in[18] + l * 8;
    for (int u = F.bid; u < nun; u += F.G) {
        if (u < nlat) { const int qb = u & 63, kvh = (u >> 6) & 1, b = u >> 7; att::attn_unit(F.ldsg, F.tid, Qb, Ob, KVb, b * SEQ + qb * 64, qb * 64, b, kvh, sink); }
        else { const int v = u - nlat, cb = v & 3, kvh = (v >> 2) & 1, b = v >> 3; att::attn_unit(F.ldsg, F.tid, Qb, Ob, KVb, ML + b * CTX + cb * 64, -1, b, kvh, sink); }
    }
}

__global__ void __launch_bounds__(512, 2) fwd_kernel(Params prm) {
    extern __shared__ __attribute__((aligned(16))) unsigned char shm[];
    Ctx F; F.p = &prm; F.lds = (LAS unsigned char*)shm; F.ldsg = (char*)shm;
    F.G = gridDim.x; F.bid = blockIdx.x;
    const int wave0 = __builtin_amdgcn_readfirstlane(threadIdx.x >> 6);
    if (threadIdx.x < 16) ((LAS unsigned*)(F.lds + LDS_BARST))[threadIdx.x] = 0u;
    __syncthreads();
    const XcdBarrier xbar = xcd_barrier_post((unsigned*)(prm.ws + OFF_CTL), (volatile LAS unsigned*)(F.lds + LDS_BARST));
    const int lo = prm.ph_lo, hi = prm.ph_hi;
    for (int ph = lo; ph < hi; ++ph) {
        if (ph > lo) { if (lo < 0) cg::this_grid().sync(); else xcd_barrier(xbar); }
        int wv_ = wave0; asm volatile("" : "+s"(wv_));
        int ln_; asm volatile("v_mbcnt_lo_u32_b32 %0, -1, 0\n\tv_mbcnt_hi_u32_b32 %0, -1, %0" : "=v"(ln_));
        F.wave = wv_; F.lane = ln_; F.tid = wv_ * 64 + ln_;
        size_t wz_ = 0; asm volatile("" : "+s"(wz_));
        unsigned char* ws = prm.ws + wz_;
        float* MOD = (float*)(ws + OFF_MOD);
        float* ctxres = (float*)(ws + OFF_CTX);
        bf16_t* GRb = (bf16_t*)(ws + OFF_GR); bf16_t* Qb = (bf16_t*)(ws + OFF_Q); bf16_t* KVb = (bf16_t*)(ws + OFF_KV); bf16_t* GLb = (bf16_t*)(ws + OFF_GL);
        bf16_t* RX = (bf16_t*)(ws + OFF_X); bf16_t* RY = (bf16_t*)(ws + OFF_Y);
        bf16_t* A2 = (bf16_t*)(ws + OFF_A2); bf16_t* Fb = (bf16_t*)(ws + OFF_F); bf16_t* Mx = (bf16_t*)(ws + OFF_MX);
        if (ph == 0) {
            if (F.bid == F.G - 1) { float* TAB = (float*)(ws + OFF_TAB);
                for (int i = F.tid; i < 64 * 32; i += 512) { const int pos = i >> 5, f = i & 31; float sn, cs; sincosf((float)pos * exp2f(-(float)f * (13.287712379549449f / 32.0f)), &sn, &cs); TAB[2 * i] = cs; TAB[2 * i + 1] = sn; } }
            mod_phase(F); __syncthreads(); convert_WA(F, 0); continue; }
        if (ph == 1) { norm_phase<false, true>(F, MT, prm.in[0], prm.in[2], nullptr, nullptr, nullptr, nullptr, 0, nullptr, nullptr, prm.in[6], MOD, 1024, 0, RY); continue; }
        const int l = (ph - 2) / 9, sp = (ph - 2) % 9;
        const bool lastl = (l == 1);
        bf16_t* Hl = l == 0 ? RY : RX; bf16_t* XRb = l == 0 ? RX : RY;
        bf16_t* HF = Hl; bf16_t* Gb = XRb; bf16_t* H2 = RX;
        const int Mg = lastl ? ML : MT;
        const float* xres_lat = l == 0 ? prm.in[0] : prm.out; const float* xres_ctx = l == 0 ? prm.in[2] : ctxres;
        const float* modl = MOD + (size_t)l * 5 * 6144;
        switch (sp) {
        case 0: { pg8::PlainOrder S; S.tm.init(MT, INW, F.G, F.bid); S.A = (const char*)Hl; S.B = (const char*)(ws + OFF_W + W_WIN); S.tsA = (size_t)256 * 1024 * 2; S.tsB = (size_t)256 * 1024 * 2; S.nt = 16;
                  pg8::EpiInProj E{XRb, GRb, Qb, KVb, GLb, (const float*)(ws + OFF_TAB)}; pg8::gemm_phase<false>(F.lds, F.tid, 1024, 1024, 1024, S, E); } break;
        case 1: { rglru_phase<1>(F, l, XRb, GRb); } break;
        case 2: { attn_phase(F, l, Qb, Qb, KVb, !lastl); __syncthreads(); rglru_phase<2>(F, l, XRb, GRb, lastl); } break;
        case 3: { pg8::ChainOrder S; S.tm.init(ML, 1024, F.G, F.bid); S.G = F.G; S.c = F.bid; S.nslice = lastl ? 0 : 64;
                  S.A0 = (const char*)GRb; S.B0 = (const char*)(ws + OFF_W + W_WOR); S.A1 = (const char*)Qb; S.B1 = (const char*)(ws + OFF_W + W_WOA);
                  S.tsA = (size_t)256 * 1024 * 2; S.tsB = (size_t)256 * 1024 * 2; S.nt = 16;
                  pg8::EpiMerge E{GLb, Gb, Hl};
                  pg8::gemm_phase<true>(F.lds, F.tid, 1024, 1024, 1024, S, E); } break;
        case 4: { if (!lastl) {
                      const bf16_t* SLg = Hl; bf16_t* Gc = Gb + (size_t)ML * 1024;
                      for (int i = F.bid * 512 + F.tid; i < 1024 * 1024 / 8; i += F.G * 512) { f32x4 a0 = {0.f, 0.f, 0.f, 0.f}, a1 = a0;
#pragma unroll
                          for (int sl = 0; sl < 4; ++sl) { const u32x4 w = *(const u32x4*)(SLg + (size_t)sl * (1024 * 1024) + (size_t)i * 8);
                              a0 = a0 + (f32x4){bflo(w.x), bfhi(w.x), bflo(w.y), bfhi(w.y)}; a1 = a1 + (f32x4){bflo(w.z), bfhi(w.z), bflo(w.w), bfhi(w.w)}; }
                          u32x4 o; o.x = cvt_pk_bf16(a0[0], a0[1]); o.y = cvt_pk_bf16(a0[2], a0[3]); o.z = cvt_pk_bf16(a1[0], a1[1]); o.w = cvt_pk_bf16(a1[2], a1[3]);
                          *(u32x4*)(Gc + (size_t)i * 8) = o; }
                      xcd_barrier(xbar); }
                  bf16_t* SLm = Mx + (size_t)MT * 1024;
                  pg8::EpiBf16 E{Mx, SLm};
                  pg8::SplitOrder S; S.tm.init(ML, 1024, F.G, F.bid); S.G = F.G; S.c = F.bid; S.nslice = lastl ? 0 : 64; S.A = (const char*)Gb; S.B = (const char*)(ws + OFF_W + W_WOUT); S.tsA = (size_t)256 * 1024 * 2; S.tsB = (size_t)256 * 1024 * 2; S.nt = 16;
                  S.ka = 4; S.kb = 4;
                  pg8::gemm_phase<false>(F.lds, F.tid, 1024, 1024, 1024, S, E); } break;
        case 5: { convert_WF(F, l);
                  norm_phase<true, true>(F, Mg, xres_lat, xres_ctx, Mx, lastl ? nullptr : Mx + (size_t)MT * 1024, prm.in[7] + l * 1024, modl, 2048, prm.out, ctxres, prm.in[8] + l * 1024, modl, 4096, 3072, H2); } break;
        case 6: { pg8::PlainOrder S; S.tm.init(Mg, INW, F.G, F.bid); S.A = (const char*)H2; S.B = (const char*)(ws + OFF_W + W_WFI); S.tsA = (size_t)256 * 1024 * 2; S.tsB = (size_t)256 * 1024 * 2; S.nt = 16;
                  pg8::EpiSwiGLU E{A2}; pg8::gemm_phase<false>(F.lds, F.tid, 1024, 1024, 1024, S, E); } break;
        case 7: { bf16_t* SLf = Fb + (size_t)MT * 1024;
                  pg8::EpiBf16 E{Fb, SLf};
                  pg8::SplitOrder S; S.tm.init(ML, 1024, F.G, F.bid); S.G = F.G; S.c = F.bid; S.nslice = lastl ? 0 : 64; S.A = (const char*)A2; S.B = (const char*)(ws + OFF_W + W_WFO); S.tsA = (size_t)256 * DFF * 2; S.tsB = (size_t)256 * DFF * 2; S.nt = 44;
                  S.ka = 12; S.kb = 10;
                  pg8::gemm_phase<false>(F.lds, F.tid, DFF, DFF, DFF, S, E); } break;
        case 8: { if (!lastl) { convert_WA(F, l + 1);
                      norm_phase<true, true>(F, MT, prm.out, ctxres, Fb, Fb + (size_t)MT * 1024, prm.in[9] + l * 1024, modl, 5120, prm.out, ctxres, prm.in[6] + (l + 1) * 1024, MOD + (size_t)(l + 1) * 5 * 6144, 1024, 0, RX); }
                  else norm_phase<true, false>(F, ML, prm.out, ctxres, Fb, nullptr, prm.in[9] + l * 1024, modl, 5120, prm.out, ctxres, nullptr, nullptr, 0, 0, nullptr); } break;
        }
    }
}

extern "C" void kernel_launch(void* const* d_in, const int* in_sizes, int n_in, void* d_out, int out_size, void* d_ws, size_t ws_size, hipStream_t stream) {
    static int grid = 0;
    if (grid == 0) {
        if (n_in != 24 || out_size != ML * DM || ws_size < WS_END) { fprintf(stderr, "kernel_launch: unexpected shapes (n_in %d out %d ws %zu need %zu)\n", n_in, out_size, ws_size, (size_t)WS_END); grid = -1; return; }
        int dev = 0, cus = 0, per_cu = 0;
        hipGetDevice(&dev); hipDeviceGetAttribute(&cus, hipDeviceAttributeMultiprocessorCount, dev);
        if (hipFuncSetAttribute((const void*)fwd_kernel, hipFuncAttributeMaxDynamicSharedMemorySize, LDS_BYTES) != hipSuccess) { fprintf(stderr, "kernel_launch: hipFuncSetAttribute failed\n"); grid = -1; return; }
        if (hipOccupancyMaxActiveBlocksPerMultiprocessor(&per_cu, (const void*)fwd_kernel, 512, LDS_BYTES) != hipSuccess || per_cu < 1) { fprintf(stderr, "kernel_launch: occupancy query gave %d\n", per_cu); per_cu = 1; }
        (void)hipGetLastError();
        grid = cus * (per_cu > 1 ? 1 : per_cu);
        fprintf(stderr, "kernel_launch: grid %d (cus %d per_cu %d)\n", grid, cus, per_cu);
    }
    if (grid < 0) return;
    Params p{};
    for (int i = 0; i < 24; ++i) p.in[i] = (const float*)d_in[i];
    p.out = (float*)d_out; p.ws = (unsigned char*)d_ws;
    if (hipMemsetAsync((char*)d_ws + OFF_CTL, 0, CTL_BYTES, stream) != hipSuccess) { fprintf(stderr, "kernel_launch: memset failed\n"); return; }
#if MK_PER_PHASE
    for (int ph = 0; ph < NPHASE; ++ph) { p.ph_lo = ph; p.ph_hi = ph + 1; hipLaunchKernelGGL(fwd_kernel, dim3(grid), dim3(512), LDS_BYTES, stream, p); }
#else
    p.ph_lo = 0; p.ph_hi = NPHASE;
    void* args[] = {&p};
    hipError_t e = hipLaunchCooperativeKernel((const void*)fwd_kernel, dim3(grid), dim3(512), args, LDS_BYTES, stream);
    if (e != hipSuccess) fprintf(stderr, "kernel_launch: cooperative launch failed: %s (grid %d)\n", hipGetErrorString(e), grid);
#endif
}
```

```cpp
#include <hip/hip_runtime.h>
#include <hip/hip_cooperative_groups.h>
#include <cstdio>
#include <cstdint>
namespace cg = cooperative_groups;

#ifndef MK_PER_PHASE
#define MK_PER_PHASE 0
#endif

#define LAS __attribute__((address_space(3)))
typedef unsigned short bf16_t;
typedef short bf16x8 __attribute__((ext_vector_type(8)));
typedef short s16x4 __attribute__((ext_vector_type(4)));
typedef float f32x4 __attribute__((ext_vector_type(4)));
typedef float f32x2 __attribute__((ext_vector_type(2)));
typedef float f32x16 __attribute__((ext_vector_type(16)));
typedef unsigned u32x4 __attribute__((ext_vector_type(4)));
typedef unsigned u32x2 __attribute__((ext_vector_type(2)));

constexpr int DM = 1024, NB = 4, SEQ = 4096, CTX = 256;
constexpr int ML = NB * SEQ, MC = NB * CTX, MT = ML + MC;
constexpr int INW = 5632, DFF = 2816, NCH = 68;
constexpr float EPS = 1e-6f;
constexpr int NPHASE = 20;

constexpr size_t MB1 = (size_t)MT * 1024 * 2;
constexpr size_t OFF_W = 0;
constexpr size_t W_WIN = 0, W_WG = 11534336, W_WOR = W_WG + 1048576, W_WOA = W_WOR + 2097152, W_WOUT = W_WOA + 2097152;
constexpr size_t W_WFI = 0, W_WFO = 11534336;
constexpr size_t OFF_CTX = 18874368;
constexpr size_t OFF_MOD = OFF_CTX + 4194304;
constexpr size_t OFF_AGG = OFF_MOD + 245760;
constexpr size_t OFF_X = OFF_AGG + 4456448;
constexpr size_t OFF_GR = OFF_X + MB1;
constexpr size_t OFF_Q = OFF_GR + MB1;
constexpr size_t OFF_KV = OFF_Q + MB1;
constexpr size_t OFF_GL = OFF_KV + (size_t)MT * 512 * 2;
constexpr size_t OFF_Y = OFF_GL + (size_t)MT * 2048 * 2;
constexpr size_t OFF_CTL = OFF_Y + MB1, CTL_BYTES = 16384;
constexpr size_t OFF_TAB = OFF_CTL + CTL_BYTES, TAB_BYTES = 64 * 32 * 8;
constexpr size_t WS_END = OFF_TAB + TAB_BYTES;
constexpr size_t OFF_A2 = OFF_GR;
constexpr size_t OFF_F = OFF_CTL - (size_t)MT * 1024 * 4;
constexpr size_t OFF_MX = OFF_GL;
static_assert(OFF_A2 + (size_t)MT * DFF * 2 <= OFF_F, "A2/F overlap");
static_assert(WS_END <= 268435456, "workspace");

constexpr int LDS_BYTES = 163840;
constexpr int LDS_BARST = LDS_BYTES - 64;

__device__ __forceinline__ unsigned cvt_pk_bf16(float lo, float hi) { unsigned r; asm volatile("v_cvt_pk_bf16_f32 %0, %1, %2" : "=v"(r) : "v"(lo), "v"(hi)); return r; }
__device__ __forceinline__ float bf2f(unsigned short v) { return __uint_as_float(((unsigned)v) << 16); }
__device__ __forceinline__ float bflo(unsigned w) { return __uint_as_float(w << 16); }
__device__ __forceinline__ float bfhi(unsigned w) { return __uint_as_float(w & 0xffff0000u); }
__device__ __forceinline__ float sigmoidf_(float x) { return __builtin_amdgcn_rcpf(1.0f + __expf(-x)); }
__device__ __forceinline__ float siluf_(float x) { return x * __builtin_amdgcn_rcpf(1.0f + __expf(-x)); }
__device__ __forceinline__ float gelu_tanh(float x) { const float u = 0.7978845608028654f * (x + 0.044715f * x * x * x); const float t = 1.0f - 2.0f * __builtin_amdgcn_rcpf(1.0f + __expf(2.0f * u)); return 0.5f * x * (1.0f + t); }
__device__ __forceinline__ float wave_sum(float v, int lane) {
#pragma unroll
    for (int o = 1; o < 64; o <<= 1) v += __uint_as_float(__builtin_amdgcn_ds_bpermute((lane ^ o) << 2, __float_as_uint(v)));
    return v;
}

namespace pg8 {
constexpr int BM = 256, BK = 64, HALF = 128, HTB = HALF * BK * 2, STAGE_BYTES = 8 * HTB, NXCD = 8, WGM = 8;
__device__ __forceinline__ int lds_byte(int r, int c) { const int st = (r >> 4) * 2 + (c >> 5), rr = r & 15, cc = c & 31, ob = rr * 64 + cc * 2; return st * 1024 + (ob ^ (((ob >> 9) & 1) << 5)); }
__device__ __forceinline__ void stage_rc(int b, int& R, int& C) { const int st = b / 1024, sb = b % 1024, swz = sb ^ (((sb >> 9) & 1) << 5); R = (st >> 1) * 16 + swz / 64; C = (st & 1) * 32 + (swz % 64) / 2; }
__device__ __forceinline__ int perm32(int rho) { const int n = rho >> 4, i = rho & 15; return 8 * (i >> 2) + 4 * n + (i & 3); }

struct Unit { int pm, pn; const char* A; const char* B; int chain; int nt; int slab; };

struct TileMap {
    int nM, nN, nwg, G, c;
    __device__ void init(int M, int N, int G_, int c_) { nM = M / BM; nN = N / BM; nwg = nM * nN; G = G_; c = c_; }
    __device__ bool tile(int i, int& pm, int& pn) const {
        const long L = (long)i * G + c; if (L >= nwg) return false;
        int wgid = (int)L; { const int q = nwg / NXCD, r = nwg % NXCD, xcd = wgid % NXCD, off = wgid / NXCD; wgid = (xcd < r ? xcd * (q + 1) : r * (q + 1) + (xcd - r) * q) + off; }
        const int nig = WGM * nN, gid = wgid / nig, fm = gid * WGM, gsz = (nM - fm) < WGM ? (nM - fm) : WGM;
        pm = fm + ((wgid % nig) % gsz); pn = (wgid % nig) / gsz; return true;
    }
};
struct PlainOrder {
    TileMap tm; const char* A; const char* B; size_t tsA, tsB; int nt;
    __device__ bool next(int i, Unit& u) const { if (!tm.tile(i, u.pm, u.pn)) return false; u.A = A + (size_t)u.pm * tsA; u.B = B + (size_t)u.pn * tsB; u.chain = 0; u.nt = nt; u.slab = -1; return true; }
};
struct SplitOrder {
    TileMap tm; const char* A; const char* B; size_t tsA, tsB; int nt; int G, c; int nslice; int ka, kb;
    __device__ bool next(int i, Unit& u) const {
        const long L = (long)i * G + c;
        if (L < 256) { if (!tm.tile(i, u.pm, u.pn)) return false; u.A = A + (size_t)u.pm * tsA; u.B = B + (size_t)u.pn * tsB; u.chain = 0; u.nt = nt; u.slab = -1; return true; }
        const int j = (int)(L - 256); if (j >= nslice) return false;
        const int t = j >> 2, sl = j & 3; u.pm = 64 + (t >> 2); u.pn = t & 3; u.chain = 0; u.slab = sl;
        const int kk = sl < 2 ? ka * sl : 2 * ka + kb * (sl - 2); u.nt = sl < 2 ? ka : kb;
        u.A = A + (size_t)u.pm * tsA + (size_t)kk * 128; u.B = B + (size_t)u.pn * tsB + (size_t)kk * 128; return true;
    }
};
struct ChainOrder {
    TileMap tm; const char* A0; const char* B0; const char* A1; const char* B1; size_t tsA, tsB; int nt; int G, c, nslice;
    __device__ bool next(int i, Unit& u) const { const int part = i & 1; u.chain = part ? 0 : 1;
        if (nslice == 0) { if (!tm.tile(i >> 1, u.pm, u.pn)) return false; u.nt = nt; u.slab = -1;
            u.A = (part ? A1 : A0) + (size_t)u.pm * tsA; u.B = (part ? B1 : B0) + (size_t)u.pn * tsB; return true; }
        const long L = (long)(i >> 1) * G + c;
        if (L < 256) { if (!tm.tile(i >> 1, u.pm, u.pn)) return false; u.nt = nt; u.slab = -1;
            u.A = (part ? A1 : A0) + (size_t)u.pm * tsA; u.B = (part ? B1 : B0) + (size_t)u.pn * tsB; return true; }
        const int j = (int)(L - 256); if (j >= nslice) return false;
        const int t = j >> 2, sl = j & 3; u.pm = 64 + (t >> 2); u.pn = t & 3; u.slab = sl; u.nt = 4;
        u.A = (part ? A1 : A0) + (size_t)u.pm * tsA + (size_t)sl * 512; u.B = (part ? B1 : B0) + (size_t)u.pn * tsB + (size_t)sl * 512; return true; }
};

template <bool CHAIN, class Epi, class Sched>
__device__ __forceinline__ void gemm_phase(LAS unsigned char* lds, const int tid, const int K, const int lda, const int ldb, const Sched& S, const Epi& E) {
    const int wid = __builtin_amdgcn_readfirstlane(tid >> 6), lane = tid & 63, wr = wid >> 2, wc = wid & 3, fr = lane & 15, fq = lane >> 4;
    unsigned voffA[2], voffB[2];
#pragma unroll
    for (int i = 0; i < 2; ++i) { int R, C; stage_rc(tid * 16 + i * 8192, R, C); const int Rb = Epi::PERM ? ((R & ~31) + perm32(R & 31)) : R;
        voffA[i] = (unsigned)(R * lda + C) * 2u; voffB[i] = (unsigned)(Rb * ldb + C) * 2u; }
    const size_t kstep = (size_t)(BK * 2);
    const size_t hstepA = (size_t)HALF * lda * 2, hstepB = (size_t)HALF * ldb * 2;
    const unsigned ldsw = (unsigned)wid * 1024u;
    const int aoff = lds_byte(wr * 64 + fr, fq * 8), boff = lds_byte(wc * 32 + fr, fq * 8);
#define PG8_SA(b, h) (((b) * 2 + (h)) * HTB)
#define PG8_SB(b, h) ((4 + (b) * 2 + (h)) * HTB)
#define PG8_STAGE(bufoff, gbase, voff) do { _Pragma("unroll") for (int _i = 0; _i < 2; ++_i) \
        __builtin_amdgcn_global_load_lds((const unsigned*)((const char*)(gbase) + (voff)[_i]), (LAS unsigned*)(lds + (bufoff) + ldsw + _i * 8192), 16, 0, 0); } while (0)
#define PG8_LDA(dst, b, h) do { _Pragma("unroll") for (int m = 0; m < 4; ++m) _Pragma("unroll") for (int k = 0; k < 2; ++k) dst[m][k] = *(const LAS bf16x8*)(lds + PG8_SA(b, h) + aoff + m * 2048 + k * 1024); } while (0)
#define PG8_LDB(dst, b, h) do { _Pragma("unroll") for (int n = 0; n < 2; ++n) _Pragma("unroll") for (int k = 0; k < 2; ++k) dst[n][k] = *(const LAS bf16x8*)(lds + PG8_SB(b, h) + boff + n * 2048 + k * 1024); } while (0)
#define PG8_MMA(ai, bj, At, Bt) do { __builtin_amdgcn_s_setprio(1); _Pragma("unroll") for (int m = 0; m < 4; ++m) _Pragma("unroll") for (int n = 0; n < 2; ++n) _Pragma("unroll") for (int k = 0; k < 2; ++k) \
        acc[ai][bj][m][n] = __builtin_amdgcn_mfma_f32_16x16x32_bf16(Bt[n][k], At[m][k], acc[ai][bj][m][n], 0, 0, 0); __builtin_amdgcn_s_setprio(0); } while (0)
#define PG8_WAIT_V(n) asm volatile("s_waitcnt vmcnt(" #n ")" ::: "memory")
#define PG8_WAIT_L(n) asm volatile("s_waitcnt lgkmcnt(" #n ")" ::: "memory")
#define PG8_BAR __builtin_amdgcn_s_barrier()
#define PG8_SCHED __builtin_amdgcn_sched_barrier(0)
#define PG8_KLOOP(cA_, cB_, nA_, nB_, nt_) do { const int nt__ = (nt_); \
        for (int t = 0; t < nt__; t += 2) { \
            const bool last = (t == nt__ - 2); \
            const char* a1 = (cA_) + (size_t)(t + 1) * kstep; \
            const char* a2 = last ? (nA_) : (cA_) + (size_t)(t + 2) * kstep; const char* b2 = last ? (nB_) : (cB_) + (size_t)(t + 2) * kstep; \
            const char* a3 = a2 + kstep; const char* b3 = b2 + kstep; \
            PG8_LDB(B0, 0, 0); PG8_LDB(B1, 0, 1); PG8_SCHED; PG8_LDA(At, 0, 0); PG8_STAGE(PG8_SA(1, 1), a1 + hstepA, voffA); \
            PG8_WAIT_V(8); PG8_WAIT_L(0); PG8_BAR; PG8_MMA(0, 0, At, B0); PG8_MMA(0, 1, At, B1); PG8_BAR; PG8_SCHED; \
            PG8_LDA(At, 0, 1); PG8_STAGE(PG8_SB(0, 0), b2, voffB); PG8_STAGE(PG8_SB(0, 1), b2 + hstepB, voffB); PG8_STAGE(PG8_SA(0, 0), a2, voffA); \
            PG8_WAIT_V(8); PG8_WAIT_L(0); PG8_BAR; PG8_MMA(1, 0, At, B0); PG8_MMA(1, 1, At, B1); PG8_BAR; PG8_SCHED; \
            PG8_LDB(B0, 1, 0); PG8_LDB(B1, 1, 1); PG8_SCHED; PG8_LDA(At, 1, 0); PG8_STAGE(PG8_SA(0, 1), a2 + hstepA, voffA); \
            PG8_WAIT_V(8); PG8_WAIT_L(0); PG8_BAR; PG8_MMA(0, 0, At, B0); PG8_MMA(0, 1, At, B1); PG8_BAR; PG8_SCHED; \
            PG8_LDA(At, 1, 1); PG8_STAGE(PG8_SB(1, 0), b3, voffB); PG8_STAGE(PG8_SB(1, 1), b3 + hstepB, voffB); PG8_STAGE(PG8_SA(1, 0), a3, voffA); \
            PG8_WAIT_V(8); PG8_WAIT_L(0); PG8_BAR; PG8_MMA(1, 0, At, B0); PG8_MMA(1, 1, At, B1); PG8_BAR; PG8_SCHED; \
        } } while (0)
#define PG8_EPI_IDS int l2_ = lane; asm volatile("" : "+v"(l2_)); const int fr2 = l2_ & 15, fq2 = l2_ >> 4
    Unit cur, nxt; int ui = 0;
    if (!S.next(0, cur)) return;
    f32x4 acc[2][2][4][2];
#pragma unroll
    for (int a = 0; a < 2; ++a)
#pragma unroll
        for (int b = 0; b < 2; ++b)
#pragma unroll
            for (int m = 0; m < 4; ++m)
#pragma unroll
                for (int n = 0; n < 2; ++n) acc[a][b][m][n] = (f32x4){0.f, 0.f, 0.f, 0.f};
    bf16x8 At[4][2], B0[2][2], B1[2][2];
    {
        const char* cA = cur.A; const char* cB = cur.B;
        PG8_STAGE(PG8_SB(0, 0), cB, voffB); PG8_STAGE(PG8_SB(0, 1), cB + hstepB, voffB); PG8_STAGE(PG8_SA(0, 0), cA, voffA); PG8_STAGE(PG8_SA(0, 1), cA + hstepA, voffA);
        if (wr == 1) PG8_BAR;
        PG8_WAIT_V(2); PG8_BAR;
        PG8_STAGE(PG8_SB(1, 0), cB + kstep, voffB); PG8_STAGE(PG8_SA(1, 0), cA + kstep, voffA); PG8_STAGE(PG8_SB(1, 1), cB + hstepB + kstep, voffB);
        PG8_WAIT_V(6); PG8_BAR;
    }
    for (;;) {
        bool has_next;
        if constexpr (CHAIN) {
            Unit c2; (void)S.next(ui + 1, c2);
            PG8_KLOOP(cur.A, cur.B, c2.A, c2.B, cur.nt);
            if (wr == 0) PG8_BAR;
            { PG8_EPI_IDS; E.mid(acc, cur, wr, wc, fr2, fq2); }
            if (wr == 1) PG8_BAR;
            ++ui;
            has_next = S.next(ui + 1, nxt);
            const char* nA = has_next ? nxt.A : c2.A; const char* nB = has_next ? nxt.B : c2.B;
            PG8_KLOOP(c2.A, c2.B, nA, nB, c2.nt);
            if (wr == 0) PG8_BAR;
            { PG8_EPI_IDS; E(acc, c2, wr, wc, fr2, fq2); }
        } else {
            has_next = S.next(ui + 1, nxt);
            const char* nA = has_next ? nxt.A : cur.A; const char* nB = has_next ? nxt.B : cur.B;
            PG8_KLOOP(cur.A, cur.B, nA, nB, cur.nt);
            if (wr == 0) PG8_BAR;
            { PG8_EPI_IDS; E(acc, cur, wr, wc, fr2, fq2); }
        }
        if (!has_next) break;
#pragma unroll
        for (int a = 0; a < 2; ++a)
#pragma unroll
            for (int b = 0; b < 2; ++b)
#pragma unroll
                for (int m = 0; m < 4; ++m)
#pragma unroll
                    for (int n = 0; n < 2; ++n) acc[a][b][m][n] = (f32x4){0.f, 0.f, 0.f, 0.f};
        cur = nxt; ++ui;
        if (wr == 1) PG8_BAR;
    }
    PG8_WAIT_V(0);
    PG8_BAR;
#undef PG8_SA
#undef PG8_SB
#undef PG8_STAGE
#undef PG8_LDA
#undef PG8_LDB
#undef PG8_MMA
#undef PG8_WAIT_V
#undef PG8_WAIT_L
#undef PG8_BAR
#undef PG8_SCHED
#undef PG8_KLOOP
#undef PG8_EPI_IDS
}

struct EpiInProj {
    static constexpr bool PERM = true;
    bf16_t *XR, *GR, *Q, *KV, *GL; const float* TAB;
    __device__ __forceinline__ void mid(f32x4 (&acc)[2][2][4][2], const Unit& u, int wr, int wc, int fr, int fq) const {}
    template <int LDC> __device__ __forceinline__ void store(const f32x4 (&acc)[2][2][4][2], bf16_t* base, int row0) const {
        bf16_t* rp = base + (size_t)row0 * LDC;
#pragma unroll
        for (int ai = 0; ai < 2; ++ai)
#pragma unroll
            for (int m = 0; m < 4; ++m) { bf16_t* rowp = rp + (size_t)(ai * HALF + m * 16) * LDC;
#pragma unroll
                for (int bj = 0; bj < 2; ++bj) { const f32x4 v0 = acc[ai][bj][m][0], v1 = acc[ai][bj][m][1];
                    u32x4 w; w.x = cvt_pk_bf16(v0[0], v0[1]); w.y = cvt_pk_bf16(v0[2], v0[3]); w.z = cvt_pk_bf16(v1[0], v1[1]); w.w = cvt_pk_bf16(v1[2], v1[3]);
                    *(u32x4*)(rowp + bj * HALF) = w; } }
    }
    template <int LDC> __device__ __forceinline__ void store_rope(const f32x4 (&acc)[2][2][4][2], bf16_t* base, int row0, int wc, int fq) const {
        bf16_t* rp = base + (size_t)row0 * LDC; const int axis = wc >> 1, f0 = 16 * (wc & 1) + 4 * fq;
#pragma unroll
        for (int ai = 0; ai < 2; ++ai)
#pragma unroll
            for (int m = 0; m < 4; ++m) { const int row = row0 + ai * HALF + m * 16; bf16_t* rowp = rp + (size_t)(ai * HALF + m * 16) * LDC;
                const int t = row & (SEQ - 1), pos = axis ? (t & 63) : (t >> 6);
                f32x4 cs0 = *(const f32x4*)(TAB + (pos * 32 + f0) * 2), cs1 = *(const f32x4*)(TAB + (pos * 32 + f0) * 2 + 4);
                if (row >= ML) { cs0 = (f32x4){1.f, 0.f, 1.f, 0.f}; cs1 = cs0; }
#pragma unroll
                for (int bj = 0; bj < 2; ++bj) { const f32x4 x1 = acc[ai][bj][m][0], x2 = acc[ai][bj][m][1];
                    u32x4 w;
                    w.x = cvt_pk_bf16(x1[0] * cs0[0] - x2[0] * cs0[1], x1[1] * cs0[2] - x2[1] * cs0[3]);
                    w.y = cvt_pk_bf16(x1[2] * cs1[0] - x2[2] * cs1[1], x1[3] * cs1[2] - x2[3] * cs1[3]);
                    w.z = cvt_pk_bf16(x2[0] * cs0[0] + x1[0] * cs0[1], x2[1] * cs0[2] + x1[1] * cs0[3]);
                    w.w = cvt_pk_bf16(x2[2] * cs1[0] + x1[2] * cs1[1], x2[3] * cs1[2] + x1[3] * cs1[3]);
                    *(u32x4*)(rowp + bj * HALF) = w; } }
    }
    __device__ __forceinline__ void operator()(const f32x4 (&acc)[2][2][4][2], const Unit& u, int wr, int wc, int fr, int fq) const {
        const int pn = u.pn; const int row0 = u.pm * BM + wr * 64 + fr, col0 = wc * 32 + 8 * fq;
        if (pn < 8) { bf16_t* base = (pn < 4 ? XR + pn * 256 : GR + (pn - 4) * 256) + col0; store<1024>(acc, base, row0); }
        else if (pn < 12) { store_rope<1024>(acc, Q + (pn - 8) * 256 + col0, row0, wc, fq); }
        else if (pn == 12) { store_rope<512>(acc, KV + col0, row0, wc, fq); }
        else if (pn == 13) { store<512>(acc, KV + 256 + col0, row0); }
        else { store<2048>(acc, GL + (pn - 14) * 256 + col0, row0); }
    }
};
struct EpiSwiGLU {
    static constexpr bool PERM = true;
    bf16_t* O;
    __device__ __forceinline__ void mid(f32x4 (&acc)[2][2][4][2], const Unit& u, int wr, int wc, int fr, int fq) const {}
    __device__ __forceinline__ void operator()(const f32x4 (&acc)[2][2][4][2], const Unit& u, int wr, int wc, int fr, int fq) const {
        const int row0 = u.pm * BM + wr * 64 + fr, col0 = u.pn * 128 + wc * 32 + 8 * fq;
#pragma unroll
        for (int ai = 0; ai < 2; ++ai)
#pragma unroll
            for (int m = 0; m < 4; ++m) { bf16_t* rowp = O + (size_t)(row0 + ai * HALF + m * 16) * DFF + col0;
                float r[8];
#pragma unroll
                for (int n = 0; n < 2; ++n)
#pragma unroll
                    for (int j = 0; j < 4; ++j) r[n * 4 + j] = siluf_(acc[ai][0][m][n][j]) * acc[ai][1][m][n][j];
                u32x4 w; w.x = cvt_pk_bf16(r[0], r[1]); w.y = cvt_pk_bf16(r[2], r[3]); w.z = cvt_pk_bf16(r[4], r[5]); w.w = cvt_pk_bf16(r[6], r[7]);
                *(u32x4*)rowp = w; }
    }
};
struct EpiMerge {
    static constexpr bool PERM = true;
    const bf16_t* GL; bf16_t* G; bf16_t* SL;
    __device__ __forceinline__ void mid(f32x4 (&acc)[2][2][4][2], const Unit& u, int wr, int wc, int fr, int fq) const {
        const int row0 = u.pm * BM + wr * 64 + fr, col0 = u.pn * BM + wc * 32 + 8 * fq;
#pragma unroll
        for (int ai = 0; ai < 2; ++ai)
#pragma unroll
            for (int m = 0; m < 4; ++m) { const bf16_t* gp = GL + (size_t)(row0 + ai * HALF + m * 16) * 2048 + col0;
#pragma unroll
                for (int bj = 0; bj < 2; ++bj) { const u32x4 la = *(const u32x4*)(gp + bj * HALF), lb = *(const u32x4*)(gp + 1024 + bj * HALF);
#pragma unroll
                    for (int n = 0; n < 2; ++n)
#pragma unroll
                        for (int j = 0; j < 4; ++j) { const int e = n * 4 + j; const unsigned wa = la[e >> 1], wb = lb[e >> 1];
                            const float a = (e & 1) ? bfhi(wa) : bflo(wa), b = (e & 1) ? bfhi(wb) : bflo(wb);
                            acc[ai][bj][m][n][j] *= (1.0f + __expf(-b)) * __builtin_amdgcn_rcpf(1.0f + __expf(-a)); }
                    asm volatile("" : "+v"(acc[ai][bj][m][0]), "+v"(acc[ai][bj][m][1]) :: "memory"); } }
    }
    __device__ __forceinline__ void operator()(const f32x4 (&acc)[2][2][4][2], const Unit& u, int wr, int wc, int fr, int fq) const {
        const int row0 = u.pm * BM + wr * 64 + fr, col0 = u.pn * BM + wc * 32 + 8 * fq;
        bf16_t* gout = u.slab < 0 ? G : SL + (size_t)u.slab * (1024 * 1024) - (size_t)ML * 1024;
#pragma unroll
        for (int ai = 0; ai < 2; ++ai)
#pragma unroll
            for (int m = 0; m < 4; ++m) { const size_t r = (size_t)(row0 + ai * HALF + m * 16);
#pragma unroll
                for (int bj = 0; bj < 2; ++bj) { const u32x4 lb = *(const u32x4*)(GL + r * 2048 + 1024 + col0 + bj * HALF); float o[8];
#pragma unroll
                    for (int n = 0; n < 2; ++n)
#pragma unroll
                        for (int j = 0; j < 4; ++j) { const int e = n * 4 + j; const unsigned wb = lb[e >> 1]; const float b = (e & 1) ? bfhi(wb) : bflo(wb);
                            o[e] = acc[ai][bj][m][n][j] * __builtin_amdgcn_rcpf(1.0f + __expf(-b)); }
                    u32x4 w; w.x = cvt_pk_bf16(o[0], o[1]); w.y = cvt_pk_bf16(o[2], o[3]); w.z = cvt_pk_bf16(o[4], o[5]); w.w = cvt_pk_bf16(o[6], o[7]);
                    *(u32x4*)(gout + r * 1024 + col0 + bj * HALF) = w; asm volatile("" ::: "memory"); } }
    }
};
struct EpiBf16 {
    static constexpr bool PERM = true;
    bf16_t* O; bf16_t* SL;
    __device__ __forceinline__ void mid(f32x4 (&acc)[2][2][4][2], const Unit& u, int wr, int wc, int fr, int fq) const {}
    __device__ __forceinline__ void operator()(const f32x4 (&acc)[2][2][4][2], const Unit& u, int wr, int wc, int fr, int fq) const {
        const int row0 = u.pm * BM + wr * 64 + fr, col0 = u.pn * BM + wc * 32 + 8 * fq;
        bf16_t* ob = u.slab < 0 ? O : SL + (size_t)u.slab * (1024 * 1024) - (size_t)ML * 1024;
#pragma unroll
        for (int ai = 0; ai < 2; ++ai)
#pragma unroll
            for (int m = 0; m < 4; ++m) { bf16_t* rowp = ob + (size_t)(row0 + ai * HALF + m * 16) * 1024 + col0;
#pragma unroll
                for (int bj = 0; bj < 2; ++bj) { const f32x4 v0 = acc[ai][bj][m][0], v1 = acc[ai][bj][m][1];
                    u32x4 w; w.x = cvt_pk_bf16(v0[0], v0[1]); w.y = cvt_pk_bf16(v0[2], v0[3]); w.z = cvt_pk_bf16(v1[0], v1[1]); w.w = cvt_pk_bf16(v1[2], v1[3]);
                    *(u32x4*)(rowp + bj * HALF) = w; } }
    }
};
struct EpiF32 {
    static constexpr bool PERM = false;
    float* O;
    __device__ __forceinline__ void mid(f32x4 (&acc)[2][2][4][2], const Unit& u, int wr, int wc, int fr, int fq) const {}
    __device__ __forceinline__ void operator()(const f32x4 (&acc)[2][2][4][2], const Unit& u, int wr, int wc, int fr, int fq) const {
        const int row0 = u.pm * BM + wr * 64 + fr, col0 = u.pn * BM + wc * 32 + 4 * fq;
#pragma unroll
        for (int ai = 0; ai < 2; ++ai)
#pragma unroll
            for (int m = 0; m < 4; ++m) { float* rowp = O + (size_t)(row0 + ai * HALF + m * 16) * 1024 + col0;
#pragma unroll
                for (int bj = 0; bj < 2; ++bj)
#pragma unroll
                    for (int n = 0; n < 2; ++n) *(f32x4*)(rowp + bj * HALF + n * 16) = acc[ai][bj][m][n]; }
    }
};
}

namespace att {
constexpr float SCALE = 0.088388347648318440f;
constexpr float THR = 8.f;
constexpr int SHM_V = 64 * 128 * 2, SHM_K = 64 * 128 * 2;
#define KSWZ(row, colB) ((row) * 256 + ((colB) ^ (((row) & 7) << 4)))
#define SBAR() __builtin_amdgcn_sched_barrier(0)
__device__ __forceinline__ int crow(int r, int hi) { return (r & 3) + 8 * (r >> 2) + 4 * hi; }
__device__ __forceinline__ void partialSM(f32x16& p0, f32x16& p1, float& m_reg, float& mn, float& alpha) {
    constexpr float C = SCALE * 1.4426950408889634f;
    float pmax = p0[0];
#pragma unroll
    for (int r = 1; r < 16; ++r) pmax = fmaxf(pmax, p0[r]);
#pragma unroll
    for (int r = 0; r < 16; ++r) pmax = fmaxf(pmax, p1[r]);
    { auto rr = __builtin_amdgcn_permlane32_swap(__float_as_uint(pmax), __float_as_uint(pmax), false, false);
      pmax = fmaxf(__uint_as_float(rr[0]), __uint_as_float(rr[1])); }
    if (__builtin_expect(__all(pmax - m_reg <= THR / SCALE), 1)) { mn = m_reg; alpha = 1.f; }
    else { mn = fmaxf(m_reg, pmax); alpha = __builtin_amdgcn_exp2f((m_reg - mn) * C); m_reg = mn; }
    const float mnC = -mn * C;
#pragma unroll
    for (int r = 0; r < 16; ++r) p0[r] = fmaf(p0[r], C, mnC);
#pragma unroll
    for (int r = 0; r < 16; ++r) p1[r] = fmaf(p1[r], C, mnC);
#pragma unroll
    for (int r = 0; r < 16; ++r) p0[r] = __builtin_amdgcn_exp2f(p0[r]);
}
__device__ __forceinline__ void finishSM(f32x16& p0, f32x16& p1, float alpha, float& l_reg, bf16x8& pa0, bf16x8& pa1, bf16x8& pa2, bf16x8& pa3) {
#pragma unroll
    for (int r = 0; r < 16; ++r) p1[r] = __builtin_amdgcn_exp2f(p1[r]);
    float ps = 0;
#pragma unroll
    for (int r = 0; r < 16; ++r) ps += p0[r];
#pragma unroll
    for (int r = 0; r < 16; ++r) ps += p1[r];
    { auto rr = __builtin_amdgcn_permlane32_swap(__float_as_uint(ps), __float_as_uint(ps), false, false);
      ps = __uint_as_float(rr[0]) + __uint_as_float(rr[1]); }
    l_reg = l_reg * alpha + ps;
#define PK4(P, BASE, OUT) do { unsigned a0 = cvt_pk_bf16(P[BASE + 0], P[BASE + 1]), a1 = cvt_pk_bf16(P[BASE + 2], P[BASE + 3]);   \
    unsigned b0 = cvt_pk_bf16(P[BASE + 4], P[BASE + 5]), b1 = cvt_pk_bf16(P[BASE + 6], P[BASE + 7]);                              \
    auto r0 = __builtin_amdgcn_permlane32_swap(a0, b0, false, false); auto r1 = __builtin_amdgcn_permlane32_swap(a1, b1, false, false); \
    u32x4 w = {r0[0], r1[0], r0[1], r1[1]}; OUT = *reinterpret_cast<bf16x8*>(&w); } while (0)
    PK4(p0, 0, pa0); PK4(p0, 8, pa1); PK4(p1, 0, pa2); PK4(p1, 8, pa3);
#undef PK4
}
__device__ __forceinline__ void qkt(f32x16& p0, f32x16& p1, const char* Ks, const bf16x8* qr, int r32, int hi) {
    p0 = f32x16{}; p1 = f32x16{};
#pragma unroll
    for (int d0 = 0; d0 < 8; ++d0) { const int cb = (d0 * 16 + hi * 8) * 2;
        const bf16x8 b0 = *reinterpret_cast<const bf16x8*>(Ks + KSWZ(r32, cb));
        const bf16x8 b1 = *reinterpret_cast<const bf16x8*>(Ks + KSWZ(32 + r32, cb));
        p0 = __builtin_amdgcn_mfma_f32_32x32x16_bf16(b0, qr[d0], p0, 0, 0, 0);
        p1 = __builtin_amdgcn_mfma_f32_32x32x16_bf16(b1, qr[d0], p1, 0, 0, 0); }
}
__device__ __forceinline__ int v_st(int k, int c) { const int kk = (k & ~0xC) | ((k & 4) << 1) | ((k & 8) >> 1); return ((kk >> 3) * 4 + (c >> 5)) * 512 + ((kk & 7) * 32 + (c & 31)) * 2; }
__device__ __forceinline__ int v_rd_base(int lane) { return ((lane & 3) << 3) | (((lane >> 2) & 3) << 6) | (((lane >> 4) & 1) << 5) | (((lane >> 5) & 1) << 8); }
constexpr int v_rd_off(int d0, int ks, int half) { return d0 * 512 + ks * 4096 + half * 2048; }
template <int OFF> __device__ __forceinline__ s16x4 tr_read(int vb) {
    s16x4 r; asm volatile("ds_read_b64_tr_b16 %0, %1 offset:%2" : "=&v"(r) : "v"(vb), "i"(OFF) : "memory"); return r;
}
template <int D0> __device__ __forceinline__ void pv_one(f32x16& od, int vb, bf16x8 pa0, bf16x8 pa1, bf16x8 pa2, bf16x8 pa3) {
    const s16x4 l0 = tr_read<v_rd_off(D0, 0, 0)>(vb), h0 = tr_read<v_rd_off(D0, 0, 1)>(vb), l1 = tr_read<v_rd_off(D0, 1, 0)>(vb), h1 = tr_read<v_rd_off(D0, 1, 1)>(vb);
    const s16x4 l2 = tr_read<v_rd_off(D0, 2, 0)>(vb), h2 = tr_read<v_rd_off(D0, 2, 1)>(vb), l3 = tr_read<v_rd_off(D0, 3, 0)>(vb), h3 = tr_read<v_rd_off(D0, 3, 1)>(vb);
    asm volatile("s_waitcnt lgkmcnt(0)" ::: "memory"); SBAR();
#define PK(L, H) (bf16x8){L[0], L[1], L[2], L[3], H[0], H[1], H[2], H[3]}
    od = __builtin_amdgcn_mfma_f32_32x32x16_bf16(pa0, PK(l0, h0), od, 0, 0, 0);
    od = __builtin_amdgcn_mfma_f32_32x32x16_bf16(pa1, PK(l1, h1), od, 0, 0, 0);
    od = __builtin_amdgcn_mfma_f32_32x32x16_bf16(pa2, PK(l2, h2), od, 0, 0, 0);
    od = __builtin_amdgcn_mfma_f32_32x32x16_bf16(pa3, PK(l3, h3), od, 0, 0, 0);
#undef PK
}

__device__ __forceinline__ void attn_unit(char* lds, const int tid, const bf16_t* Qb, bf16_t* Ob, const bf16_t* KVb, int qrow0, int t0, int b, int kvh, const float* sink_l) {
    const int wid = tid >> 6, lane = tid & 63, r32 = lane & 31, hi = lane >> 5;
    char* V_lds = lds; char* K_lds = lds + 2 * SHM_V;
    float* ws = (float*)(lds + 2 * SHM_V + 2 * SHM_K) + wid * 64; float* li_l = ws; float* al_l = ws + 32;
    const int h = kvh * 4 + (wid >> 1);
    const int qoff = (wid & 1) * 32;
    bf16x8 qr[8];
    { const bf16_t* Qw = Qb + (size_t)(qrow0 + qoff + r32) * 1024 + h * 128 + hi * 8;
#pragma unroll
      for (int d0 = 0; d0 < 8; ++d0) qr[d0] = *reinterpret_cast<const bf16x8*>(Qw + d0 * 16); }
    float m_reg = sink_l[h] / SCALE, l_reg = 1.f;
    f32x16 o[4] = {};
    int ks_first = 0, nbt = 0;
    if (t0 >= 0) { ks_first = t0 - 128 < 0 ? 0 : t0 - 128; const int ke = t0 + 192 > SEQ ? SEQ : t0 + 192; nbt = (ke - ks_first) >> 6; }
    const int NT = nbt + 4;
    const int sr = tid >> 4, sc = (tid & 15) * 8, vst0 = v_st(sr, sc), vst1 = v_st(32 + sr, sc);
    const int vb0 = (int)(uintptr_t)V_lds + v_rd_base(lane);
    bf16x8 vs0, vs1, ks0, ks1;
#define TROW(j) ((j) < nbt ? b * SEQ + ks_first + 64 * (j) : ML + b * CTX + 64 * ((j) - nbt))
#define SLOAD(j) do { const bf16_t* kp = KVb + (size_t)(TROW(j) + sr) * 512 + kvh * 128 + sc; \
    ks0 = *reinterpret_cast<const bf16x8*>(kp); ks1 = *reinterpret_cast<const bf16x8*>(kp + 32 * 512); \
    vs0 = *reinterpret_cast<const bf16x8*>(kp + 256); vs1 = *reinterpret_cast<const bf16x8*>(kp + 256 + 32 * 512); } while (0)
#define SWRITE(bu) do { *(bf16x8*)(V_lds + (bu) * SHM_V + vst0) = vs0; *(bf16x8*)(V_lds + (bu) * SHM_V + vst1) = vs1; const int kc = sc * 2; \
    *(bf16x8*)(K_lds + (bu) * SHM_K + KSWZ(sr, kc)) = ks0; *(bf16x8*)(K_lds + (bu) * SHM_K + KSWZ(32 + sr, kc)) = ks1; } while (0)
    SLOAD(0); SWRITE(0); __syncthreads();
    const int qpos = t0 + qoff + r32;
    for (int j = 0; j < NT; ++j) {
        const int bu = j & 1;
        f32x16 p0, p1; float mn, alpha; bf16x8 pa0, pa1, pa2, pa3;
        qkt(p0, p1, K_lds + bu * SHM_K, qr, r32, hi);
        const int kw = ks_first + 64 * j - (t0 + qoff);
        if (j < nbt && (kw + 63 > 128 || kw < -97)) { const int kb = ks_first + 64 * j - qpos;
#pragma unroll
            for (int r = 0; r < 16; ++r) { const int d0 = kb + crow(r, hi), d1 = d0 + 32;
                if (d0 > 128 || d0 < -128) p0[r] = -1e30f; if (d1 > 128 || d1 < -128) p1[r] = -1e30f; } }
        partialSM(p0, p1, m_reg, mn, alpha);
        if (__any(alpha < 1.f)) { if (hi == 0) al_l[r32] = alpha; asm volatile("s_waitcnt lgkmcnt(0)" ::: "memory");
#pragma unroll
            for (int d = 0; d < 4; ++d)
#pragma unroll
                for (int r = 0; r < 16; ++r) o[d][r] *= al_l[crow(r, hi)]; }
        finishSM(p0, p1, alpha, l_reg, pa0, pa1, pa2, pa3); SBAR();
        if (j + 1 < NT) SLOAD(j + 1);
        SBAR();
        const int vb = vb0 + bu * SHM_V;
        pv_one<0>(o[0], vb, pa0, pa1, pa2, pa3); pv_one<1>(o[1], vb, pa0, pa1, pa2, pa3); pv_one<2>(o[2], vb, pa0, pa1, pa2, pa3); pv_one<3>(o[3], vb, pa0, pa1, pa2, pa3);
        if (j + 1 < NT) SWRITE(bu ^ 1);
        __syncthreads();
    }
    if (hi == 0) li_l[r32] = l_reg; asm volatile("s_waitcnt lgkmcnt(0)" ::: "memory");
    bf16_t* Ow = Ob + (size_t)(qrow0 + qoff) * 1024 + h * 128;
#pragma unroll
    for (int r = 0; r < 16; ++r) { const int orow = crow(r, hi); const float rl = __builtin_amdgcn_rcpf(li_l[orow]);
#pragma unroll
        for (int d0 = 0; d0 < 4; ++d0) { const unsigned w = cvt_pk_bf16(o[d0][r] * rl, 0.f); Ow[(size_t)orow * 1024 + d0 * 32 + r32] = (bf16_t)(w & 0xffffu); } }
#undef TROW
#undef SLOAD
#undef SWRITE
}
}

#define XB_TMO      128
#define XB_XCNT(j)  (256  + 64 * (j))
#define XB_XSUB(j)  (1280 + 64 * (j))
#define XB_XGEN(j)  (2304 + 64 * (j))
#define XB_TOP      3328
#define XB_TOPGEN   3392
#define XCD_BAR_WORDS 3456
#define XB_SPIN_CAP (1u << 18)
__device__ __forceinline__ unsigned xb_ld(unsigned* p)              { return __hip_atomic_load(p, __ATOMIC_RELAXED, __HIP_MEMORY_SCOPE_AGENT); }
__device__ __forceinline__ unsigned xb_add(unsigned* p, unsigned v) { return __hip_atomic_fetch_add(p, v, __ATOMIC_RELAXED, __HIP_MEMORY_SCOPE_AGENT); }
__device__ __forceinline__ unsigned xb_xcc_id() { return (unsigned)__builtin_amdgcn_s_getreg((3 << 11) | 20) & 0xFu; }
#define XB_SPIN(cond, bar) do { unsigned _sp = 0; while (cond) { __builtin_amdgcn_s_sleep(1); \
    if ((++_sp & 255u) == 0u) { if (xb_ld(&(bar)[XB_TMO])) break; if (_sp > XB_SPIN_CAP) { atomicAdd(&(bar)[XB_TMO], 1u); break; } } } } while (0)
struct XcdBarrier { unsigned* bar; unsigned x; volatile LAS unsigned* st; };
__device__ __forceinline__ XcdBarrier xcd_barrier_post(unsigned* bar, volatile LAS unsigned* st) {
    XcdBarrier b; b.bar = bar; b.x = xb_xcc_id(); b.st = st;
    if (threadIdx.x == 0) (void)xb_add(&bar[XB_XCNT(b.x)], 1u);
    return b;
}
__device__ __forceinline__ void xcd_barrier_complete(unsigned* bar, unsigned x, unsigned& nloc, unsigned& nx) {
    const unsigned G = gridDim.x * gridDim.y * gridDim.z;
    unsigned sum, cnt, mine, sp = 0u;
    for (;;) {
        sum = 0u; cnt = 0u; mine = 0u;
#pragma unroll
        for (unsigned j = 0; j < 16; ++j) { const unsigned c = xb_ld(&bar[XB_XCNT(j)]); sum += c; cnt += (c > 0u) ? 1u : 0u; mine = (j == x) ? c : mine; }
        if (sum == G) break;
        __builtin_amdgcn_s_sleep(1);
        if ((++sp & 255u) == 0u) { if (xb_ld(&bar[XB_TMO])) break; if (sp > XB_SPIN_CAP) { atomicAdd(&bar[XB_TMO], 1u); break; } }
    }
    nloc = mine > 0u ? mine : 1u; nx = cnt > 0u ? cnt : 1u;
}
__device__ __forceinline__ void xcd_barrier(const XcdBarrier& b) {
    asm volatile("s_waitcnt vmcnt(0)" ::: "memory");
    __syncthreads();
    if (threadIdx.x == 0) {
        unsigned* bar = b.bar;
        __builtin_amdgcn_s_waitcnt(0);
        unsigned nloc = b.st[0], nx = b.st[1];
        if (nloc == 0u) { xcd_barrier_complete(bar, b.x, nloc, nx); b.st[0] = nloc; b.st[1] = nx; }
        const unsigned old = xb_add(&bar[XB_XSUB(b.x)], 1u);
        const unsigned gen = old / nloc;
        if (old + 1u == (gen + 1u) * nloc) {
            __builtin_amdgcn_fence(__ATOMIC_RELEASE, "agent");
            asm volatile("s_waitcnt vmcnt(0)" ::: "memory");
            const unsigned og = xb_add(&bar[XB_TOP], 1u);
            const unsigned tg = og / nx;
            if (og + 1u == (tg + 1u) * nx) xb_add(&bar[XB_TOPGEN], 1u);
            else XB_SPIN(xb_ld(&bar[XB_TOPGEN]) == tg, bar);
            __builtin_amdgcn_fence(__ATOMIC_ACQUIRE, "agent");
            xb_add(&bar[XB_XGEN(b.x)], 1u);
            asm volatile("s_waitcnt vmcnt(0)" ::: "memory");
        } else {
            XB_SPIN(xb_ld(&bar[XB_XGEN(b.x)]) == gen, bar);
            __builtin_amdgcn_fence(__ATOMIC_ACQUIRE, "agent");
            asm volatile("s_waitcnt vmcnt(0)" ::: "memory");
        }
    }
    __syncthreads();
}

struct Params { const float* in[24]; float* out; unsigned char* ws; int ph_lo, ph_hi; };

struct Ctx {
    const Params* p; LAS unsigned char* lds; char* ldsg; int tid, lane, wave, G, bid;
};

__device__ __forceinline__ int rope_perm_col(int c) {
    const int d = c & 63, n = d >> 5, f = d & 31; return (c & ~63) + 32 * (f >> 4) + 8 * ((f >> 2) & 3) + 4 * n + (f & 3);
}
struct TItem { const float* W; bf16_t* WT; int ldw, ldt, k0, n0, drow0, rperm; float scale; };
__device__ __forceinline__ void titem_load(const TItem& t, float (&tv)[32], int lane) {
#pragma unroll
    for (int i = 0; i < 32; ++i) tv[i] = t.scale * __builtin_nontemporal_load(t.W + (size_t)(t.k0 + i) * t.ldw + t.n0 + lane);
}
__device__ __forceinline__ void titem_store(const TItem& t, const float (&tv)[32], LAS float* scr, int lane) {
#pragma unroll
    for (int i = 0; i < 32; ++i) scr[i * 65 + lane] = tv[i];
    asm volatile("s_waitcnt lgkmcnt(0)" ::: "memory");
    const int c = lane & 3;
#pragma unroll
    for (int j = 0; j < 4; ++j) { const int n = (lane >> 2) + 16 * j; const LAS float* s = scr + (8 * c) * 65 + n;
        u32x4 o; o.x = cvt_pk_bf16(s[0 * 65], s[1 * 65]); o.y = cvt_pk_bf16(s[2 * 65], s[3 * 65]); o.z = cvt_pk_bf16(s[4 * 65], s[5 * 65]); o.w = cvt_pk_bf16(s[6 * 65], s[7 * 65]);
        const int drow = t.rperm ? rope_perm_col(t.drow0 + n) : t.drow0 + n;
        *(u32x4*)(t.WT + (size_t)drow * t.ldt + t.k0 + 8 * c) = o; }
    asm volatile("s_waitcnt lgkmcnt(0)" ::: "memory");
}
constexpr int WA_ITEMS = 32 * 88 + 3 * 32 * 16 + 256;
__device__ __forceinline__ TItem decode_WA(const Params& P, int l, int it) {
    unsigned char* W = P.ws + OFF_W; TItem t; constexpr int I_IN = 32 * 88, I_SQ = 32 * 16;
    int r = it; t.scale = 1.0f;
    if (r < I_IN) { const int kb = r / 88, nb = r % 88; t.W = P.in[10] + (size_t)l * 1024 * INW; t.ldw = INW; t.k0 = kb * 32; t.n0 = nb * 64; t.WT = (bf16_t*)(W + W_WIN); t.ldt = 1024; t.drow0 = nb * 64; t.rperm = (nb >= 32 && nb < 52) ? 1 : 0; return t; }
    r -= I_IN;
    if (r < 3 * I_SQ) { const int which = r / I_SQ; r %= I_SQ; const int kb = r / 16, nb = r % 16; t.W = P.in[19 + which] + (size_t)l * 1024 * 1024; t.ldw = 1024; t.k0 = kb * 32; t.n0 = nb * 64;
        t.WT = (bf16_t*)(W + (which == 0 ? W_WOR : which == 1 ? W_WOA : W_WOUT)); t.ldt = 1024; t.drow0 = nb * 64; t.rperm = 0; return t; }
    r -= 3 * I_SQ;
    { const int mat = r >> 3, sub = r & 7, kb = sub >> 1, nb = sub & 1; const int dir = mat >> 4, g = (mat >> 3) & 1, blk = mat & 7;
      t.W = P.in[g ? 15 : 13] + ((size_t)(l * 2 + dir) * 8 + blk) * 128 * 128; t.ldw = 128; t.k0 = kb * 32; t.n0 = nb * 64; t.WT = (bf16_t*)(W + W_WG) + (size_t)mat * 128 * 128; t.ldt = 128; t.drow0 = nb * 64; t.rperm = 0; t.scale = -1.4426950408889634f; return t; }
}
constexpr int WF_ITEMS = 32 * 88 + 88 * 16;
__device__ __forceinline__ TItem decode_WF(const Params& P, int l, int it) {
    unsigned char* W = P.ws + OFF_W; TItem t; constexpr int I_FI = 32 * 88;
    int r = it; t.rperm = 0; t.scale = 1.0f;
    if (r < I_FI) { const int kb = r / 88, nb = r % 88; const int n0 = nb * 64; const int up = n0 >= DFF ? 1 : 0, nn = n0 - up * DFF;
        t.W = P.in[22] + (size_t)l * 1024 * INW; t.ldw = INW; t.k0 = kb * 32; t.n0 = n0; t.WT = (bf16_t*)(W + W_WFI); t.ldt = 1024; t.drow0 = 256 * (nn >> 7) + 128 * up + (nn & 127); return t; }
    r -= I_FI;
    { const int kb = r / 16, nb = r % 16; t.W = P.in[23] + (size_t)l * DFF * 1024; t.ldw = 1024; t.k0 = kb * 32; t.n0 = nb * 64; t.WT = (bf16_t*)(W + W_WFO); t.ldt = DFF; t.drow0 = nb * 64; return t; }
}
template <bool FFN>
__device__ __forceinline__ void convert_weights(const Ctx& F, int l) {
    const Params& P = *F.p;
    LAS float* scr = (LAS float*)(F.lds + F.wave * 16384);
    const int gw = F.bid * 8 + F.wave, NGW = F.G * 8; constexpr int NIT = FFN ? WF_ITEMS : WA_ITEMS;
    if (gw >= NIT) return;
    float tva[32], tvb[32];
    TItem ca = FFN ? decode_WF(P, l, gw) : decode_WA(P, l, gw), cb = ca;
    titem_load(ca, tva, F.lane);
    for (int it = gw; it < NIT; it += 2 * NGW) {
        const bool hb = it + NGW < NIT;
        if (hb) { cb = FFN ? decode_WF(P, l, it + NGW) : decode_WA(P, l, it + NGW); titem_load(cb, tvb, F.lane); }
        titem_store(ca, tva, scr, F.lane);
        if (!hb) break;
        const bool ha = it + 2 * NGW < NIT;
        if (ha) { ca = FFN ? decode_WF(P, l, it + 2 * NGW) : decode_WA(P, l, it + 2 * NGW); titem_load(ca, tva, F.lane); }
        titem_store(cb, tvb, scr, F.lane);
        if (!ha) break;
    }
}
__device__ __forceinline__ void convert_WA(const Ctx& F, int l) { convert_weights<false>(F, l); }
__device__ __forceinline__ void convert_WF(const Ctx& F, int l) { convert_weights<true>(F, l); }

__device__ __forceinline__ void mod_phase(const Ctx& F) {
    const Params& P = *F.p; float* MOD = (float*)(P.ws + OFF_MOD);
    LAS float* sv = (LAS float*)F.lds;
    LAS float* red = (LAS float*)(F.lds + 32768);
    if (F.bid >= 192) return;
    for (int i = F.tid; i < 1024; i += 512) {
#pragma unroll
        for (int r = 0; r < 4; ++r) sv[i * 8 + r] = siluf_(P.in[1][r * 1024 + i]);
        sv[i * 8 + 4] = siluf_(P.in[3][i]); sv[i * 8 + 5] = 0.f; sv[i * 8 + 6] = 0.f; sv[i * 8 + 7] = 0.f; }
    __syncthreads();
    for (int it = F.bid; it < 192; it += F.G) {
        const int l = it / 96, n0 = (it % 96) * 64;
        const float* Wm = P.in[4] + (size_t)l * 1024 * 6144 + n0 + F.lane;
        float a0 = 0, a1 = 0, a2 = 0, a3 = 0, a4 = 0;
        const int kb = F.wave * 128;
#pragma unroll 32
        for (int k = 0; k < 128; ++k) { const float w = __builtin_nontemporal_load(Wm + (size_t)(kb + k) * 6144); const LAS float* s = sv + (kb + k) * 8;
            const f32x4 s4 = *(const LAS f32x4*)s; a0 += s4[0] * w; a1 += s4[1] * w; a2 += s4[2] * w; a3 += s4[3] * w; a4 += s[4] * w; }
        red[(F.wave * 5 + 0) * 64 + F.lane] = a0; red[(F.wave * 5 + 1) * 64 + F.lane] = a1; red[(F.wave * 5 + 2) * 64 + F.lane] = a2;
        red[(F.wave * 5 + 3) * 64 + F.lane] = a3; red[(F.wave * 5 + 4) * 64 + F.lane] = a4;
        __syncthreads();
        if (F.wave < 5) { float s = 0;
#pragma unroll
            for (int w = 0; w < 8; ++w) s += red[(w * 5 + F.wave) * 64 + F.lane];
            MOD[(size_t)(l * 5 + F.wave) * 6144 + n0 + F.lane] = s + P.in[5][l * 6144 + n0 + F.lane]; }
        __syncthreads();
    }
}

template <bool BR, bool WH>
__device__ __forceinline__ void norm_phase(const Ctx& F, int nrows, const float* xin_lat, const float* xin_ctx, const bf16_t* branch, const bf16_t* slabs, const float* g_post, const float* mod_g, int gate_off,
                                           float* xout_lat, float* xout_ctx, const float* g_pre, const float* mod_h, int sc_off, int sh_off, bf16_t* Hout) {
    const int gw = F.bid * 8 + F.wave, NGW = F.G * 8, lane = F.lane;
    f32x4 xc[4], xn[4]; u32x2 bc[4], bn[4];
#define NORM_LOAD(row_, X_, B_) do { const int r__ = (row_); const float* xr = r__ < ML ? xin_lat + (size_t)r__ * 1024 : xin_ctx + (size_t)(r__ - ML) * 1024; \
        _Pragma("unroll") for (int j = 0; j < 4; ++j) X_[j] = __builtin_nontemporal_load((const f32x4*)(xr + 4 * lane + 256 * j)); \
        if (BR) { if (slabs != nullptr && r__ >= ML) { _Pragma("unroll") for (int j = 0; j < 4; ++j) { f32x4 a = {0.f, 0.f, 0.f, 0.f}; \
                      _Pragma("unroll") for (int sl = 0; sl < 4; ++sl) { const u32x2 bw = *(const u32x2*)(slabs + (size_t)sl * (1024 * 1024) + (size_t)(r__ - ML) * 1024 + 4 * lane + 256 * j); a = a + (f32x4){bflo(bw.x), bfhi(bw.x), bflo(bw.y), bfhi(bw.y)}; } \
                      B_[j].x = cvt_pk_bf16(a[0], a[1]); B_[j].y = cvt_pk_bf16(a[2], a[3]); } } \
                  else { _Pragma("unroll") for (int j = 0; j < 4; ++j) B_[j] = __builtin_nontemporal_load((const u32x2*)(branch + (size_t)r__ * 1024 + 4 * lane + 256 * j)); } } } while (0)
    if (gw >= nrows) return;
    NORM_LOAD(gw, xc, bc);
    for (int row = gw; row < nrows; row += NGW) {
        const bool hn = row + NGW < nrows;
        if (hn) NORM_LOAD(row + NGW, xn, bn);
        const int mrow = row < ML ? (row >> 12) : 4;
        f32x4 x[4];
#pragma unroll
        for (int j = 0; j < 4; ++j) x[j] = xc[j];
        if (BR) {
            f32x4 m[4]; float s = 0.f;
#pragma unroll
            for (int j = 0; j < 4; ++j) { m[j] = (f32x4){bflo(bc[j].x), bfhi(bc[j].x), bflo(bc[j].y), bfhi(bc[j].y)};
                s += (m[j][0] * m[j][0] + m[j][1] * m[j][1]) + (m[j][2] * m[j][2] + m[j][3] * m[j][3]); }
            const float rs = rsqrtf(wave_sum(s, lane) * (1.f / 1024.f) + EPS);
            float* xo = row < ML ? xout_lat + (size_t)row * 1024 : xout_ctx + (size_t)(row - ML) * 1024;
#pragma unroll
            for (int j = 0; j < 4; ++j) { const f32x4 gp = *(const f32x4*)(g_post + 4 * lane + 256 * j), ga = *(const f32x4*)(mod_g + (size_t)mrow * 6144 + gate_off + 4 * lane + 256 * j);
                x[j] = x[j] + ga * ((m[j] * rs) * gp); __builtin_nontemporal_store(x[j], (f32x4*)(xo + 4 * lane + 256 * j)); }
        }
        if (WH) {
            float s = 0.f;
#pragma unroll
            for (int j = 0; j < 4; ++j) s += (x[j][0] * x[j][0] + x[j][1] * x[j][1]) + (x[j][2] * x[j][2] + x[j][3] * x[j][3]);
            const float rs = rsqrtf(wave_sum(s, lane) * (1.f / 1024.f) + EPS);
#pragma unroll
            for (int j = 0; j < 4; ++j) { const f32x4 gp = *(const f32x4*)(g_pre + 4 * lane + 256 * j), sc = *(const f32x4*)(mod_h + (size_t)mrow * 6144 + sc_off + 4 * lane + 256 * j),
                    sh = *(const f32x4*)(mod_h + (size_t)mrow * 6144 + sh_off + 4 * lane + 256 * j);
                const f32x4 hv = ((x[j] * rs) * gp) * (sc + 1.0f) + sh;
                u32x2 w; w.x = cvt_pk_bf16(hv[0], hv[1]); w.y = cvt_pk_bf16(hv[2], hv[3]);
                *(u32x2*)(Hout + (size_t)row * 1024 + 4 * lane + 256 * j) = w; }
        }
        if (!hn) break;
#pragma unroll
        for (int j = 0; j < 4; ++j) { xc[j] = xn[j]; bc[j] = bn[j]; }
    }
#undef NORM_LOAD
}

__device__ __forceinline__ void rope_phase(const Ctx& F, bf16_t* Qb, bf16_t* KVb) {
    const int gw = F.bid * 8 + F.wave, NGW = F.G * 8, lane = F.lane;
    const int axis = lane >> 5, f = lane & 31;
    const float inv = exp2f(-(float)f * (13.287712379549449f / 32.0f));
    for (int row = gw; row < ML; row += NGW) {
        const int t = row & (SEQ - 1); const int pos = axis ? (t & 63) : (t >> 6);
        float sn, cs; sincosf((float)pos * inv, &sn, &cs);
        bf16_t* q = Qb + (size_t)row * 1024 + axis * 64 + f;
#pragma unroll
        for (int h = 0; h < 8; ++h) { const float x1 = bf2f(q[h * 128]), x2 = bf2f(q[h * 128 + 32]);
            const unsigned w = cvt_pk_bf16(x1 * cs - x2 * sn, x2 * cs + x1 * sn); q[h * 128] = (bf16_t)(w & 0xffff); q[h * 128 + 32] = (bf16_t)(w >> 16); }
        bf16_t* k = KVb + (size_t)row * 512 + axis * 64 + f;
#pragma unroll
        for (int h = 0; h < 2; ++h) { const float x1 = bf2f(k[h * 128]), x2 = bf2f(k[h * 128 + 32]);
            const unsigned w = cvt_pk_bf16(x1 * cs - x2 * sn, x2 * cs + x1 * sn); k[h * 128] = (bf16_t)(w & 0xffff); k[h * 128 + 32] = (bf16_t)(w >> 16); }
    }
}

constexpr int XT_LD = 136;
constexpr int RG_XT_BYTES = 64 * XT_LD * 2;
constexpr int RG_CW_OFF = RG_XT_BYTES, RG_CW_BYTES = 3072;
constexpr int RG_SC_OFF = RG_CW_OFF + RG_CW_BYTES;
constexpr int RG_SC_BYTES = 16640 + 1152;
template <int PASS>
__device__ __forceinline__ void rglru_phase(const Ctx& F, int l, const bf16_t* XRb, bf16_t* GRb, bool latent_only = false) {
    const Params& P = *F.p;
    const int tid = F.tid, lane = F.lane, wave = F.wave;
    LAS bf16_t* XT = (LAS bf16_t*)F.lds;
    LAS float* CW = (LAS float*)(F.lds + RG_CW_OFF);
    LAS float* SCF = (LAS float*)(F.lds + RG_SC_OFF + wave * RG_SC_BYTES);
    LAS f32x2* AB = (LAS f32x2*)SCF;
    LAS float* CAR = (LAS float*)(F.lds + RG_SC_OFF + wave * RG_SC_BYTES + 16640);
    f32x2* AGG = (f32x2*)(P.ws + OFF_AGG);
    const bf16_t* WgT = (const bf16_t*)(P.ws + OFF_W + W_WG);
    const float* convw = P.in[11] + (size_t)l * 4 * 1024; const float* convb = P.in[12] + (size_t)l * 1024;
    const int cw = wave * 16, l15 = lane & 15, l4 = lane >> 4;
    const int tt = tid >> 3, cs = (tid & 7) * 16;
    for (int su = F.bid; su < 256; su += F.G) {
        const int pair = su >> 3, rg = su & 7, b = pair >> 3, blk = pair & 7;
        const int c0 = latent_only ? 4 + 8 * rg : (rg < 4 ? 9 * rg : 36 + 8 * (rg - 4)), c1 = latent_only ? 12 + 8 * rg : (rg < 3 ? 9 * (rg + 1) : 36 + 8 * (rg - 3));
        __syncthreads();
        for (int i = tid; i < 640; i += 512) CW[i] = i < 512 ? convw[(i >> 7) * 1024 + blk * 128 + (i & 127)] : convb[blk * 128 + (i - 512)];
        bf16x8 Bf[4][4];
#pragma unroll
        for (int gt = 0; gt < 4; ++gt)
#pragma unroll
            for (int ks = 0; ks < 4; ++ks) Bf[gt][ks] = *(const bf16x8*)(WgT + ((size_t)(gt * 8 + blk) * 128 + cw + l15) * 128 + ks * 32 + 8 * l4);
        const int ch = blk * 128 + cw + l15;
        float nba[2], nbx[2], cl2[2];
#pragma unroll
        for (int d = 0; d < 2; ++d) { nba[d] = -1.4426950408889634f * P.in[14][(l * 2 + d) * 1024 + ch]; nbx[d] = -1.4426950408889634f * P.in[16][(l * 2 + d) * 1024 + ch];
            cl2[d] = -8.0f * 1.4426950408889634f * log1pf(__expf(-P.in[17][(l * 2 + d) * 1024 + ch])); }
        if (PASS == 2) {
#pragma unroll 1
            for (int d = 0; d < 2; ++d) {
                __builtin_amdgcn_wave_barrier();
                for (int k = l4; k < NCH; k += 4) AB[k * 16 + l15] = AGG[((size_t)(b * 2 + d) * NCH + k) * 1024 + ch];
                asm volatile("s_waitcnt vmcnt(0) lgkmcnt(0)" ::: "memory"); __builtin_amdgcn_wave_barrier();
                if (lane < 16) { float h = 0.f;
#pragma unroll 4
                    for (int q = 0; q < NCH; ++q) { const int c = d ? (q < 4 ? 3 - q : 71 - q) : q;
                        if (c >= c0 && c < c1) CAR[(d * 9 + (c - c0)) * 16 + lane] = h;
                        const f32x2 ag = AB[c * 16 + lane]; h = ag[0] * h + ag[1]; } }
                asm volatile("s_waitcnt lgkmcnt(0)" ::: "memory"); __builtin_amdgcn_wave_barrier();
            }
        }
        u32x4 xin[4][2];
#define RG_LOADX(c_) do { const int c__ = (c_); const int sr0 = c__ < 4 ? ML + b * CTX : b * SEQ, sl = c__ < 4 ? CTX : SEQ, t0_ = c__ < 4 ? 64 * c__ : 64 * (c__ - 4); \
        _Pragma("unroll") for (int k = 0; k < 4; ++k) { const int tl = t0_ + tt + k - 2; \
            if (tl >= 0 && tl < sl) { const bf16_t* xp = XRb + (size_t)(sr0 + tl) * 1024 + blk * 128 + cs; xin[k][0] = *(const u32x4*)xp; xin[k][1] = *(const u32x4*)(xp + 8); } \
            else { xin[k][0] = (u32x4){0u, 0u, 0u, 0u}; xin[k][1] = (u32x4){0u, 0u, 0u, 0u}; } } } while (0)
        RG_LOADX(c0);
        for (int c = c0; c < c1; ++c) {
            const int seg_row0 = c < 4 ? ML + b * CTX : b * SEQ, tl0 = c < 4 ? 64 * c : 64 * (c - 4);
            __syncthreads();
            {
                float y[16];
#pragma unroll
                for (int e = 0; e < 4; ++e) { const f32x4 bv = *(const LAS f32x4*)(CW + 512 + cs + 4 * e); y[4 * e] = bv[0]; y[4 * e + 1] = bv[1]; y[4 * e + 2] = bv[2]; y[4 * e + 3] = bv[3]; }
#pragma unroll
                for (int k = 0; k < 4; ++k)
#pragma unroll
                    for (int e = 0; e < 4; ++e) { const f32x4 wv = *(const LAS f32x4*)(CW + k * 128 + cs + 4 * e); const unsigned w0 = xin[k][e >> 1][2 * (e & 1)], w1 = xin[k][e >> 1][2 * (e & 1) + 1];
                        y[4 * e] += bflo(w0) * wv[0]; y[4 * e + 1] += bfhi(w0) * wv[1]; y[4 * e + 2] += bflo(w1) * wv[2]; y[4 * e + 3] += bfhi(w1) * wv[3]; }
                u32x4 o0, o1; o0.x = cvt_pk_bf16(y[0], y[1]); o0.y = cvt_pk_bf16(y[2], y[3]); o0.z = cvt_pk_bf16(y[4], y[5]); o0.w = cvt_pk_bf16(y[6], y[7]);
                o1.x = cvt_pk_bf16(y[8], y[9]); o1.y = cvt_pk_bf16(y[10], y[11]); o1.z = cvt_pk_bf16(y[12], y[13]); o1.w = cvt_pk_bf16(y[14], y[15]);
                *(LAS u32x4*)(XT + tt * XT_LD + cs) = o0; *(LAS u32x4*)(XT + tt * XT_LD + cs + 8) = o1;
            }
            __syncthreads();
            if (c + 1 < c1) RG_LOADX(c + 1);
            u32x4 g0, g1;
            if (PASS == 2) { const bf16_t* gp = GRb + (size_t)(seg_row0 + tl0 + lane) * 1024 + blk * 128 + cw; g0 = *(const u32x4*)gp; g1 = *(const u32x4*)(gp + 8); }
            float aggA[2] = {1.f, 1.f}, aggB[2] = {0.f, 0.f};
            float hF = PASS == 2 ? CAR[(0 * 9 + (c - c0)) * 16 + l15] : 0.f;
            float hfv[4][4], ba_[4][4], bb_[4][4], bAe[4], bBe[4], bAt[4], bBt[4];
#pragma unroll
            for (int mt = 0; mt < 4; ++mt) {
                f32x4 ag[4];
#pragma unroll
                for (int gt = 0; gt < 4; ++gt) { const float nb = (gt & 1) ? nbx[gt >> 1] : nba[gt >> 1]; ag[gt] = (f32x4){nb, nb, nb, nb}; }
#pragma unroll
                for (int ks = 0; ks < 4; ++ks) { const bf16x8 af = *(const LAS bf16x8*)(XT + (mt * 16 + l15) * XT_LD + ks * 32 + 8 * l4);
#pragma unroll
                    for (int gt = 0; gt < 4; ++gt) ag[gt] = __builtin_amdgcn_mfma_f32_16x16x32_bf16(af, Bf[gt][ks], ag[gt], 0, 0, 0); }
                float ea[2][4], eb[2][4];
#pragma unroll
                for (int r = 0; r < 4; ++r) { const int tok = mt * 16 + 4 * l4 + r;
                    const float xv = bf2f(XT[tok * XT_LD + cw + l15]);
#pragma unroll
                    for (int d = 0; d < 2; ++d) {
                        const float e1 = 1.0f + __builtin_amdgcn_exp2f(ag[2 * d][r]), e2 = 1.0f + __builtin_amdgcn_exp2f(ag[2 * d + 1][r]);
                        const float inv = __builtin_amdgcn_rcpf(e1 * e2); const float rgate = e2 * inv, igate = e1 * inv;
                        const float a = __builtin_amdgcn_exp2f(rgate * cl2[d]);
                        const float om = fmaf(-a, a, 1.0f);
                        const float bv = __builtin_amdgcn_sqrtf(om) * (igate * xv);
                        ea[d][r] = a; eb[d][r] = bv; } }
                if (PASS == 1) {
#pragma unroll
                    for (int d = 0; d < 2; ++d) {
                        float A, B;
                        if (d == 0) { A = ea[0][0]; B = eb[0][0];
#pragma unroll
                            for (int r = 1; r < 4; ++r) { B = ea[0][r] * B + eb[0][r]; A *= ea[0][r]; } }
                        else { A = ea[1][3]; B = eb[1][3];
#pragma unroll
                            for (int r = 2; r >= 0; --r) { B = ea[1][r] * B + eb[1][r]; A *= ea[1][r]; } }
                        { const float Ap = __uint_as_float(__builtin_amdgcn_ds_bpermute((lane ^ 16) << 2, __float_as_uint(A))), Bp = __uint_as_float(__builtin_amdgcn_ds_bpermute((lane ^ 16) << 2, __float_as_uint(B)));
                          const bool mefirst = d == 0 ? ((l4 & 1) == 0) : ((l4 & 1) == 1);
                          const float nB = mefirst ? Ap * B + Bp : A * Bp + B; A = A * Ap; B = nB; }
                        { const float Ap = __uint_as_float(__builtin_amdgcn_ds_bpermute((lane ^ 32) << 2, __float_as_uint(A))), Bp = __uint_as_float(__builtin_amdgcn_ds_bpermute((lane ^ 32) << 2, __float_as_uint(B)));
                          const bool mefirst = d == 0 ? (l4 < 2) : (l4 >= 2);
                          const float nB = mefirst ? Ap * B + Bp : A * Bp + B; A = A * Ap; B = nB; }
                        if (d == 0) { aggB[0] = A * aggB[0] + B; aggA[0] *= A; }
                        else { aggB[1] = aggA[1] * B + aggB[1]; aggA[1] *= A; }
                    }
                }
                if (PASS == 2) {
#define BPF(src_, v_) __uint_as_float(__builtin_amdgcn_ds_bpermute(((src_) & 63) << 2, __float_as_uint(v_)))
                    {
                        float A = ea[0][0], B = eb[0][0];
#pragma unroll
                        for (int r = 1; r < 4; ++r) { B = ea[0][r] * B + eb[0][r]; A *= ea[0][r]; }
                        { const float Ap = BPF(lane - 16, A), Bp = BPF(lane - 16, B); if (l4 >= 1) { B = A * Bp + B; A = A * Ap; } }
                        { const float Ap = BPF(lane - 32, A), Bp = BPF(lane - 32, B); if (l4 >= 2) { B = A * Bp + B; A = A * Ap; } }
                        const float At = BPF(48 + l15, A), Bt = BPF(48 + l15, B);
                        float Ae = BPF(lane - 16, A), Be = BPF(lane - 16, B); if (l4 == 0) { Ae = 1.f; Be = 0.f; }
                        float h = Ae * hF + Be;
#pragma unroll
                        for (int r = 0; r < 4; ++r) { h = ea[0][r] * h + eb[0][r]; hfv[mt][r] = h; }
                        hF = At * hF + Bt;
                    }
                    {
                        float A = ea[1][3], B = eb[1][3];
#pragma unroll
                        for (int r = 2; r >= 0; --r) { B = ea[1][r] * B + eb[1][r]; A *= ea[1][r]; }
                        { const float Ap = BPF(lane + 16, A), Bp = BPF(lane + 16, B); if (l4 <= 2) { B = A * Bp + B; A = A * Ap; } }
                        { const float Ap = BPF(lane + 32, A), Bp = BPF(lane + 32, B); if (l4 <= 1) { B = A * Bp + B; A = A * Ap; } }
                        bAt[mt] = BPF(l15, A); bBt[mt] = BPF(l15, B);
                        float Ae = BPF(lane + 16, A), Be = BPF(lane + 16, B); if (l4 == 3) { Ae = 1.f; Be = 0.f; }
                        bAe[mt] = Ae; bBe[mt] = Be;
#pragma unroll
                        for (int r = 0; r < 4; ++r) { ba_[mt][r] = ea[1][r]; bb_[mt][r] = eb[1][r]; }
                    }
                }
            }
            if (PASS == 1) { if (lane < 16) { AGG[((size_t)(b * 2 + 0) * NCH + c) * 1024 + ch] = (f32x2){aggA[0], aggB[0]}; AGG[((size_t)(b * 2 + 1) * NCH + c) * 1024 + ch] = (f32x2){aggA[1], aggB[1]}; } }
            asm volatile("s_waitcnt lgkmcnt(0)" ::: "memory"); __builtin_amdgcn_wave_barrier();
            if (PASS == 2) {
                float hB = CAR[(1 * 9 + (c - c0)) * 16 + l15];
#pragma unroll
                for (int mt = 3; mt >= 0; --mt) { float h = bAe[mt] * hB + bBe[mt];
#pragma unroll
                    for (int r = 3; r >= 0; --r) { h = ba_[mt][r] * h + bb_[mt][r]; SCF[(r + 4 * mt + 16 * l4) * 17 + l15] = hfv[mt][r] + h; }
                    hB = bAt[mt] * hB + bBt[mt]; }
                asm volatile("s_waitcnt lgkmcnt(0)" ::: "memory"); __builtin_amdgcn_wave_barrier();
                const size_t go = (size_t)(seg_row0 + tl0 + lane) * 1024 + blk * 128 + cw;
                float u[16];
                const int pl = (lane & 3) + 4 * (lane >> 4) + 16 * ((lane >> 2) & 3);
#pragma unroll
                for (int e = 0; e < 16; ++e) { const float hs = SCF[pl * 17 + e]; const unsigned gw = e < 8 ? g0[e >> 1] : g1[(e - 8) >> 1];
                    u[e] = hs * gelu_tanh((e & 1) ? bfhi(gw) : bflo(gw)); }
                u32x4 o0, o1; o0.x = cvt_pk_bf16(u[0], u[1]); o0.y = cvt_pk_bf16(u[2], u[3]); o0.z = cvt_pk_bf16(u[4], u[5]); o0.w = cvt_pk_bf16(u[6], u[7]);
                o1.x = cvt_pk_bf16(u[8], u[9]); o1.y = cvt_pk_bf16(u[10], u[11]); o1.z = cvt_pk_bf16(u[12], u[13]); o1.w = cvt_pk_bf16(u[14], u[15]);
                *(u32x4*)(GRb + go) = o0; *(u32x4*)(GRb + go + 8) = o1;
            }
            __builtin_amdgcn_wave_barrier();
        }
#undef RG_LOADX
#undef BPF
    }
}

__device__ __forceinline__ void attn_phase(const Ctx& F, int l, const bf16_t* Qb, bf16_t* Ob, const bf16_t* KVb, bool with_ctx) {
    const Params& P = *F.p;
    const int nlat = NB * 2 * 64, nun = nlat + (with_ctx ? NB * 2 * 4 : 0);
    const float* sink = P.in[18] + l * 8;
    for (int u = F.bid; u < nun; u += F.G) {
        if (u < nlat) { const int qb = u & 63, kvh = (u >> 6) & 1, b = u >> 7; att::attn_unit(F.ldsg, F.tid, Qb, Ob, KVb, b * SEQ + qb * 64, qb * 64, b, kvh, sink); }
        else { const int v = u - nlat, cb = v & 3, kvh = (v >> 2) & 1, b = v >> 3; att::attn_unit(F.ldsg, F.tid, Qb, Ob, KVb, ML + b * CTX + cb * 64, -1, b, kvh, sink); }
    }
}

__global__ void __launch_bounds__(512, 2) fwd_kernel(Params prm) {
    extern __shared__ __attribute__((aligned(16))) unsigned char shm[];
    Ctx F; F.p = &prm; F.lds = (LAS unsigned char*)shm; F.ldsg = (char*)shm;
    F.G = gridDim.x; F.bid = blockIdx.x;
    const int wave0 = __builtin_amdgcn_readfirstlane(threadIdx.x >> 6);
    if (threadIdx.x < 16) ((LAS unsigned*)(F.lds + LDS_BARST))[threadIdx.x] = 0u;
    __syncthreads();
    const XcdBarrier xbar = xcd_barrier_post((unsigned*)(prm.ws + OFF_CTL), (volatile LAS unsigned*)(F.lds + LDS_BARST));
    const int lo = prm.ph_lo, hi = prm.ph_hi;
    for (int ph = lo; ph < hi; ++ph) {
        if (ph > lo) { if (lo < 0) cg::this_grid().sync(); else xcd_barrier(xbar); }
        int wv_ = wave0; asm volatile("" : "+s"(wv_));
        int ln_; asm volatile("v_mbcnt_lo_u32_b32 %0, -1, 0\n\tv_mbcnt_hi_u32_b32 %0, -1, %0" : "=v"(ln_));
        F.wave = wv_; F.lane = ln_; F.tid = wv_ * 64 + ln_;
        size_t wz_ = 0; asm volatile("" : "+s"(wz_));
        unsigned char* ws = prm.ws + wz_;
        float* MOD = (float*)(ws + OFF_MOD);
        float* ctxres = (float*)(ws + OFF_CTX);
        bf16_t* GRb = (bf16_t*)(ws + OFF_GR); bf16_t* Qb = (bf16_t*)(ws + OFF_Q); bf16_t* KVb = (bf16_t*)(ws + OFF_KV); bf16_t* GLb = (bf16_t*)(ws + OFF_GL);
        bf16_t* RX = (bf16_t*)(ws + OFF_X); bf16_t* RY = (bf16_t*)(ws + OFF_Y);
        bf16_t* A2 = (bf16_t*)(ws + OFF_A2); bf16_t* Fb = (bf16_t*)(ws + OFF_F); bf16_t* Mx = (bf16_t*)(ws + OFF_MX);
        if (ph == 0) {
            if (F.bid == F.G - 1) { float* TAB = (float*)(ws + OFF_TAB);
                for (int i = F.tid; i < 64 * 32; i += 512) { const int pos = i >> 5, f = i & 31; float sn, cs; sincosf((float)pos * exp2f(-(float)f * (13.287712379549449f / 32.0f)), &sn, &cs); TAB[2 * i] = cs; TAB[2 * i + 1] = sn; } }
            mod_phase(F); __syncthreads(); convert_WA(F, 0); continue; }
        if (ph == 1) { norm_phase<false, true>(F, MT, prm.in[0], prm.in[2], nullptr, nullptr, nullptr, nullptr, 0, nullptr, nullptr, prm.in[6], MOD, 1024, 0, RY); continue; }
        const int l = (ph - 2) / 9, sp = (ph - 2) % 9;
        const bool lastl = (l == 1);
        bf16_t* Hl = l == 0 ? RY : RX; bf16_t* XRb = l == 0 ? RX : RY;
        bf16_t* HF = Hl; bf16_t* Gb = XRb; bf16_t* H2 = RX;
        const int Mg = lastl ? ML : MT;
        const float* xres_lat = l == 0 ? prm.in[0] : prm.out; const float* xres_ctx = l == 0 ? prm.in[2] : ctxres;
        const float* modl = MOD + (size_t)l * 5 * 6144;
        switch (sp) {
        case 0: { pg8::PlainOrder S; S.tm.init(MT, INW, F.G, F.bid); S.A = (const char*)Hl; S.B = (const char*)(ws + OFF_W + W_WIN); S.tsA = (size_t)256 * 1024 * 2; S.tsB = (size_t)256 * 1024 * 2; S.nt = 16;
                  pg8::EpiInProj E{XRb, GRb, Qb, KVb, GLb, (const float*)(ws + OFF_TAB)}; pg8::gemm_phase<false>(F.lds, F.tid, 1024, 1024, 1024, S, E); } break;
        case 1: { rglru_phase<1>(F, l, XRb, GRb); } break;
        case 2: { attn_phase(F, l, Qb, Qb, KVb, !lastl); __syncthreads(); rglru_phase<2>(F, l, XRb, GRb, lastl); } break;
        case 3: { pg8::ChainOrder S; S.tm.init(ML, 1024, F.G, F.bid); S.G = F.G; S.c = F.bid; S.nslice = lastl ? 0 : 64;
                  S.A0 = (const char*)GRb; S.B0 = (const char*)(ws + OFF_W + W_WOR); S.A1 = (const char*)Qb; S.B1 = (const char*)(ws + OFF_W + W_WOA);
                  S.tsA = (size_t)256 * 1024 * 2; S.tsB = (size_t)256 * 1024 * 2; S.nt = 16;
                  pg8::EpiMerge E{GLb, Gb, Hl};
                  pg8::gemm_phase<true>(F.lds, F.tid, 1024, 1024, 1024, S, E); } break;
        case 4: { if (!lastl) {
                      const bf16_t* SLg = Hl; bf16_t* Gc = Gb + (size_t)ML * 1024;
                      for (int i = F.bid * 512 + F.tid; i < 1024 * 1024 / 8; i += F.G * 512) { f32x4 a0 = {0.f, 0.f, 0.f, 0.f}, a1 = a0;
#pragma unroll
                          for (int sl = 0; sl < 4; ++sl) { const u32x4 w = *(const u32x4*)(SLg + (size_t)sl * (1024 * 1024) + (size_t)i * 8);
                              a0 = a0 + (f32x4){bflo(w.x), bfhi(w.x), bflo(w.y), bfhi(w.y)}; a1 = a1 + (f32x4){bflo(w.z), bfhi(w.z), bflo(w.w), bfhi(w.w)}; }
                          u32x4 o; o.x = cvt_pk_bf16(a0[0], a0[1]); o.y = cvt_pk_bf16(a0[2], a0[3]); o.z = cvt_pk_bf16(a1[0], a1[1]); o.w = cvt_pk_bf16(a1[2], a1[3]);
                          *(u32x4*)(Gc + (size_t)i * 8) = o; }
                      xcd_barrier(xbar); }
                  bf16_t* SLm = Mx + (size_t)MT * 1024;
                  pg8::EpiBf16 E{Mx, SLm};
                  pg8::SplitOrder S; S.tm.init(ML, 1024, F.G, F.bid); S.G = F.G; S.c = F.bid; S.nslice = lastl ? 0 : 64; S.A = (const char*)Gb; S.B = (const char*)(ws + OFF_W + W_WOUT); S.tsA = (size_t)256 * 1024 * 2; S.tsB = (size_t)256 * 1024 * 2; S.nt = 16;
                  S.ka = 4; S.kb = 4;
                  pg8::gemm_phase<false>(F.lds, F.tid, 1024, 1024, 1024, S, E); } break;
        case 5: { convert_WF(F, l);
                  norm_phase<true, true>(F, Mg, xres_lat, xres_ctx, Mx, lastl ? nullptr : Mx + (size_t)MT * 1024, prm.in[7] + l * 1024, modl, 2048, prm.out, ctxres, prm.in[8] + l * 1024, modl, 4096, 3072, H2); } break;
        case 6: { pg8::PlainOrder S; S.tm.init(Mg, INW, F.G, F.bid); S.A = (const char*)H2; S.B = (const char*)(ws + OFF_W + W_WFI); S.tsA = (size_t)256 * 1024 * 2; S.tsB = (size_t)256 * 1024 * 2; S.nt = 16;
                  pg8::EpiSwiGLU E{A2}; pg8::gemm_phase<false>(F.lds, F.tid, 1024, 1024, 1024, S, E); } break;
        case 7: { bf16_t* SLf = Fb + (size_t)MT * 1024;
                  pg8::EpiBf16 E{Fb, SLf};
                  pg8::SplitOrder S; S.tm.init(ML, 1024, F.G, F.bid); S.G = F.G; S.c = F.bid; S.nslice = lastl ? 0 : 64; S.A = (const char*)A2; S.B = (const char*)(ws + OFF_W + W_WFO); S.tsA = (size_t)256 * DFF * 2; S.tsB = (size_t)256 * DFF * 2; S.nt = 44;
                  S.ka = 12; S.kb = 10;
                  pg8::gemm_phase<false>(F.lds, F.tid, DFF, DFF, DFF, S, E); } break;
        case 8: { if (!lastl) { convert_WA(F, l + 1);
                      norm_phase<true, true>(F, MT, prm.out, ctxres, Fb, Fb + (size_t)MT * 1024, prm.in[9] + l * 1024, modl, 5120, prm.out, ctxres, prm.in[6] + (l + 1) * 1024, MOD + (size_t)(l + 1) * 5 * 6144, 1024, 0, RX); }
                  else norm_phase<true, false>(F, ML, prm.out, ctxres, Fb, nullptr, prm.in[9] + l * 1024, modl, 5120, prm.out, ctxres, nullptr, nullptr, 0, 0, nullptr); } break;
        }
    }
}

extern "C" void kernel_launch(void* const* d_in, const int* in_sizes, int n_in, void* d_out, int out_size, void* d_ws, size_t ws_size, hipStream_t stream) {
    static int grid = 0;
    if (grid == 0) {
        if (n_in != 24 || out_size != ML * DM || ws_size < WS_END) { fprintf(stderr, "kernel_launch: unexpected shapes (n_in %d out %d ws %zu need %zu)\n", n_in, out_size, ws_size, (size_t)WS_END); grid = -1; return; }
        int dev = 0, cus = 0, per_cu = 0;
        hipGetDevice(&dev); hipDeviceGetAttribute(&cus, hipDeviceAttributeMultiprocessorCount, dev);
        if (hipFuncSetAttribute((const void*)fwd_kernel, hipFuncAttributeMaxDynamicSharedMemorySize, LDS_BYTES) != hipSuccess) { fprintf(stderr, "kernel_launch: hipFuncSetAttribute failed\n"); grid = -1; return; }
        if (hipOccupancyMaxActiveBlocksPerMultiprocessor(&per_cu, (const void*)fwd_kernel, 512, LDS_BYTES) != hipSuccess || per_cu < 1) { fprintf(stderr, "kernel_launch: occupancy query gave %d\n", per_cu); per_cu = 1; }
        (void)hipGetLastError();
        grid = cus * (per_cu > 1 ? 1 : per_cu);
        fprintf(stderr, "kernel_launch: grid %d (cus %d per_cu %d)\n", grid, cus, per_cu);
    }
    if (grid < 0) return;
    Params p{};
    for (int i = 0; i < 24; ++i) p.in[i] = (const float*)d_in[i];
    p.out = (float*)d_out; p.ws = (unsigned char*)d_ws;
    if (hipMemsetAsync((char*)d_ws + OFF_CTL, 0, CTL_BYTES, stream) != hipSuccess) { fprintf(stderr, "kernel_launch: memset failed\n"); return; }
#if MK_PER_PHASE
    for (int ph = 0; ph < NPHASE; ++ph) { p.ph_lo = ph; p.ph_hi = ph + 1; hipLaunchKernelGGL(fwd_kernel, dim3(grid), dim3(512), LDS_BYTES, stream, p); }
#else
    p.ph_lo = 0; p.ph_hi = NPHASE;
    void* args[] = {&p};
    hipError_t e = hipLaunchCooperativeKernel((const void*)fwd_kernel, dim3(grid), dim3(512), args, LDS_BYTES, stream);
    if (e != hipSuccess) fprintf(stderr, "kernel_launch: cooperative launch failed: %s (grid %d)\n", hipGetErrorString(e), grid);
#endif
}
```
